# Optimizing an MI355X kernel written in HIP

```python
import jax, jax.numpy as jnp
from jax import lax
import numpy as np

D_MODEL = 1024
BATCH = 8
SEQ = 2048
DEPTH = 1
DEC_BATCH = 128
DEC_SEQ = 4
PAST_LEN = 16384
PAGE_SIZE = 128

MIX_WIDTH = D_MODEL
GLA_WIDTH = MIX_WIDTH // 2
GMLP_WIDTH = MIX_WIDTH - GLA_WIDTH
GLA_HEADS = 4
GLA_DV = GLA_WIDTH // GLA_HEADS
GLA_KEY = GLA_WIDTH // 2
GLA_DK = GLA_KEY // GLA_HEADS
GLA_GATE_RANK = 16
GLA_TAU = 16.0
GLA_CHUNK = 64
GMLP_HEADS = 4
GMLP_DC = GMLP_WIDTH // GMLP_HEADS
GMLP_CHUNK = 128
D_FF = 2816
CONV_W = 3
PLE_DIM = 256
EPS = 1e-6
IN_SIZES = (GLA_KEY, GLA_KEY, GLA_WIDTH, GLA_WIDTH, GLA_GATE_RANK, GMLP_WIDTH, GMLP_WIDTH)
IN_COLS = sum(IN_SIZES)
SPLIT_POINTS = tuple(int(s) for s in np.cumsum(IN_SIZES)[:-1])

kernel_name = 'hymba_gla_sgu_convffn_step'


def _rmsnorm(x, g):
    xf = x.astype(jnp.float32)
    y = xf * lax.rsqrt(jnp.mean(xf * xf, axis=-1, keepdims=True) + EPS)
    return (y * g.astype(jnp.float32)).astype(x.dtype)


def _gla_chunk(S, q, k, v, g):
    b = jnp.cumsum(g, axis=2)
    b_last = b[:, :, -1, :]
    o_inter = jnp.einsum('nhld,nhde->nhle', q * jnp.exp(b), S)
    c = q.shape[2]
    causal = jnp.tril(jnp.ones((c, c), dtype=bool))
    diff = b[:, :, :, None, :] - b[:, :, None, :, :]
    decay = jnp.exp(jnp.where(causal[:, :, None], diff, -jnp.inf))
    scores = jnp.einsum('nhid,nhjd,nhijd->nhij', q, k, decay)
    o_intra = jnp.einsum('nhij,nhje->nhie', scores, v)
    k_dec = k * jnp.exp(b_last[:, :, None, :] - b)
    S_new = jnp.exp(b_last)[..., None] * S + jnp.einsum('nhld,nhle->nhde', k_dec, v)
    return S_new, o_inter + o_intra


def _to_chunks(t, c):
    n, h, l, d = t.shape
    return jnp.moveaxis(t.reshape(n, h, l // c, c, d), 2, 0)


def _gla(q, k, v, g, S0):
    q, k, v, g = (jnp.transpose(t, (0, 2, 1, 3)) for t in (q, k, v, g))
    n, h, l, dv = v.shape
    c = min(GLA_CHUNK, l)
    xs = (_to_chunks(q, c), _to_chunks(k, c), _to_chunks(v, c), _to_chunks(g, c))
    S, o = lax.scan(lambda s, inp: _gla_chunk(s, *inp), S0, xs)
    o = jnp.moveaxis(o, 0, 2).reshape(n, h, l, dv)
    return jnp.transpose(o, (0, 2, 1, 3)), S


def _sgu(u, v, g_ln, b_ln, w_s, b_s):
    n, l, _ = v.shape
    vh = v.reshape(n, l, GMLP_HEADS, GMLP_DC).astype(jnp.float32)
    mu = jnp.mean(vh, axis=-1, keepdims=True)
    var = jnp.mean(jnp.square(vh - mu), axis=-1, keepdims=True)
    vn = ((vh - mu) * lax.rsqrt(var + EPS)).reshape(n, l, GMLP_WIDTH)
    vn = (vn * g_ln.astype(jnp.float32) + b_ln.astype(jnp.float32)).astype(v.dtype)
    c = min(GMLP_CHUNK, l)
    w = w_s[:, :c, :c] * jnp.tril(jnp.ones((c, c), dtype=w_s.dtype))
    vc = vn.reshape(n, l // c, c, GMLP_HEADS, GMLP_DC)
    mixed = jnp.einsum('hts,bnshd->bnthd', w, vc) + jnp.transpose(b_s[:, :c])[:, :, None]
    return u * mixed.reshape(n, l, GMLP_WIDTH), vn


def _conv_ffn(h, prefix, w_up, w_conv, b_conv, w_down):
    up = h @ w_up
    full = jnp.concatenate([prefix.astype(up.dtype), up], axis=1)
    l = up.shape[1]
    conv = b_conv
    for j in range(CONV_W):
        conv = conv + full[:, j:j + l] * w_conv[j]
    gate, val = jnp.split(conv, 2, axis=-1)
    y = (jax.nn.gelu(gate) * val) @ w_down
    return y, full[:, -(CONV_W - 1):]


def _layer(x, p, S0, conv_prefix, lw):
    n, l, _ = x.shape
    h = _rmsnorm(x, lw['g_mix_pre'])
    proj = h @ lw['w_in']
    q, k, v, r, glr, u, vs = jnp.split(proj, SPLIT_POINTS, axis=-1)
    gate_logit = (glr @ lw['w_gla_gate'] + lw['b_gla_gate']).astype(jnp.float32)
    g = jax.nn.log_sigmoid(gate_logit) / GLA_TAU
    qh = q.astype(jnp.float32).reshape(n, l, GLA_HEADS, GLA_DK) * (GLA_DK ** -0.5)
    kh = k.astype(jnp.float32).reshape(n, l, GLA_HEADS, GLA_DK)
    vh = v.astype(jnp.float32).reshape(n, l, GLA_HEADS, GLA_DV)
    gh = g.reshape(n, l, GLA_HEADS, GLA_DK)
    o, S_new = _gla(qh, kh, vh, gh, S0.astype(jnp.float32))
    o = _rmsnorm(o, lw['g_gla_out']).reshape(n, l, GLA_WIDTH).astype(x.dtype) * jax.nn.silu(r)
    s_out, v_rows = _sgu(jax.nn.gelu(u), jax.nn.gelu(vs), lw['g_sgu_ln'], lw['b_sgu_ln'],
                         lw['w_spatial'], lw['b_spatial'])
    mix = jnp.concatenate([o, s_out], axis=-1) @ lw['w_out']
    x = x + _rmsnorm(mix, lw['g_mix_post'])
    f, conv_new = _conv_ffn(_rmsnorm(x, lw['g_ffn_pre']), conv_prefix, lw['w_up'], lw['w_conv'],
                            lw['b_conv'], lw['w_down'])
    x = x + _rmsnorm(f, lw['g_ffn_post'])
    gate = jax.nn.sigmoid(_rmsnorm(x, lw['g_ple_in']) @ lw['w_ple_gate'])
    x = x + _rmsnorm((p @ lw['w_ple']) * gate, lw['g_ple_post'])
    return x, S_new, conv_new, v_rows


def setup_inputs(seed: int = 0) -> dict:
    key = jax.random.key(seed)
    ks = jax.random.split(key, 32)
    f32 = jnp.float32
    nrm = lambda k, shape, scale: jax.random.normal(k, shape, f32) * scale
    gain = lambda k, dim: 1.0 + 0.02 * jax.random.normal(k, (DEPTH, dim), f32)
    return {
        'x_prompt': nrm(ks[0], (BATCH, SEQ, D_MODEL), 1.0),
        'x_sample': nrm(ks[1], (DEC_BATCH, DEC_SEQ, D_MODEL), 1.0),
        'state_gla': nrm(ks[2], (DEPTH, DEC_BATCH, GLA_HEADS, GLA_DK, GLA_DV), 1.0),
        'state_ffn_conv': nrm(ks[3], (DEPTH, DEC_BATCH, CONV_W - 1, 2 * D_FF), 1.0),
        'p_prompt': nrm(ks[4], (DEPTH, BATCH, SEQ, PLE_DIM), 1.0),
        'p_sample': nrm(ks[5], (DEPTH, DEC_BATCH, DEC_SEQ, PLE_DIM), 1.0),
        'g_mix_pre': gain(ks[6], D_MODEL),
        'w_in': nrm(ks[7], (DEPTH, D_MODEL, IN_COLS), D_MODEL ** -0.5),
        'w_gla_gate': nrm(ks[8], (DEPTH, GLA_GATE_RANK, GLA_KEY), GLA_GATE_RANK ** -0.5),
        'b_gla_gate': nrm(ks[9], (DEPTH, GLA_KEY), 0.1),
        'g_gla_out': gain(ks[10], GLA_DV),
        'g_sgu_ln': gain(ks[11], GMLP_WIDTH),
        'b_sgu_ln': nrm(ks[12], (DEPTH, GMLP_WIDTH), 0.02),
        'w_spatial': nrm(ks[13], (DEPTH, GMLP_HEADS, GMLP_CHUNK, GMLP_CHUNK), GMLP_CHUNK ** -0.5),
        'b_spatial': 1.0 + nrm(ks[14], (DEPTH, GMLP_HEADS, GMLP_CHUNK), 0.02),
        'w_out': nrm(ks[15], (DEPTH, MIX_WIDTH, D_MODEL), MIX_WIDTH ** -0.5),
        'g_mix_post': gain(ks[16], D_MODEL),
        'g_ffn_pre': gain(ks[17], D_MODEL),
        'w_up': nrm(ks[18], (DEPTH, D_MODEL, 2 * D_FF), D_MODEL ** -0.5),
        'w_conv': nrm(ks[19], (DEPTH, CONV_W, 2 * D_FF), CONV_W ** -0.5),
        'b_conv': nrm(ks[20], (DEPTH, 2 * D_FF), 0.02),
        'w_down': nrm(ks[21], (DEPTH, D_FF, D_MODEL), D_FF ** -0.5),
        'g_ffn_post': gain(ks[22], D_MODEL),
        'g_ple_in': gain(ks[23], D_MODEL),
        'w_ple_gate': nrm(ks[24], (DEPTH, D_MODEL, D_MODEL), D_MODEL ** -0.5),
        'w_ple': nrm(ks[25], (DEPTH, PLE_DIM, D_MODEL), PLE_DIM ** -0.5),
        'g_ple_post': gain(ks[26], D_MODEL),
    }


def reference(x_prompt, x_sample, state_gla, state_ffn_conv, p_prompt, p_sample,
              g_mix_pre, w_in, w_gla_gate, b_gla_gate, g_gla_out, g_sgu_ln, b_sgu_ln,
              w_spatial, b_spatial, w_out, g_mix_post, g_ffn_pre, w_up, w_conv, b_conv,
              w_down, g_ffn_post, g_ple_in, w_ple_gate, w_ple, g_ple_post):
    yp, ys = x_prompt, x_sample
    nb = x_prompt.shape[0]
    gla_p, gla_s, conv_p, conv_s, vrows_s = [], [], [], [], []
    for i in range(DEPTH):
        lw = {
            'g_mix_pre': g_mix_pre[i], 'w_in': w_in[i], 'w_gla_gate': w_gla_gate[i],
            'b_gla_gate': b_gla_gate[i], 'g_gla_out': g_gla_out[i], 'g_sgu_ln': g_sgu_ln[i],
            'b_sgu_ln': b_sgu_ln[i], 'w_spatial': w_spatial[i], 'b_spatial': b_spatial[i],
            'w_out': w_out[i], 'g_mix_post': g_mix_post[i], 'g_ffn_pre': g_ffn_pre[i],
            'w_up': w_up[i], 'w_conv': w_conv[i], 'b_conv': b_conv[i], 'w_down': w_down[i],
            'g_ffn_post': g_ffn_post[i], 'g_ple_in': g_ple_in[i], 'w_ple_gate': w_ple_gate[i],
            'w_ple': w_ple[i], 'g_ple_post': g_ple_post[i],
        }
        S0p = jnp.zeros((nb, GLA_HEADS, GLA_DK, GLA_DV), jnp.float32)
        c0p = jnp.zeros((nb, CONV_W - 1, 2 * D_FF), yp.dtype)
        yp, Sp, cp, _ = _layer(yp, p_prompt[i], S0p, c0p, lw)
        ys, Ss, cs, vr = _layer(ys, p_sample[i], state_gla[i], state_ffn_conv[i], lw)
        gla_p.append(Sp)
        gla_s.append(Ss)
        conv_p.append(cp)
        conv_s.append(cs)
        vrows_s.append(vr)
    new_state_gla_prompt = jnp.stack(gla_p)
    new_state_gla_sample = jnp.stack(gla_s)
    new_state_ffn_conv_prompt = jnp.stack(conv_p)
    new_state_ffn_conv_sample = jnp.stack(conv_s)
    new_state_sgu_v_sample = jnp.stack(vrows_s)
    return (yp, ys, new_state_gla_prompt, new_state_gla_sample, new_state_ffn_conv_prompt,
            new_state_ffn_conv_sample, new_state_sgu_v_sample)
```

```cpp
#include <hip/hip_runtime.h>
#include <hip/hip_cooperative_groups.h>
#include <cstdio>
namespace cg = cooperative_groups;

#define LAS __attribute__((address_space(3)))
typedef unsigned short u16;
typedef short bf16x8 __attribute__((ext_vector_type(8)));
typedef float f32x4 __attribute__((ext_vector_type(4)));
typedef float f32x2 __attribute__((ext_vector_type(2)));
typedef unsigned u32x4 __attribute__((ext_vector_type(4)));
typedef unsigned u32x2 __attribute__((ext_vector_type(2)));

constexpr int TP = 16384, TS = 512, T = TP + TS, D = 1024, NPROJ = 2816, NIN = 2576, FF = 2816, FF2 = 5632, PLE = 256;
constexpr int C_Q = 0, C_K = 256, C_V = 512, C_R = 1024, C_GLR = 1536, C_U = 1552, C_VS = 2064;
constexpr float EPS = 1e-6f;
constexpr size_t O_Y = 0, O_GLAP = 17301504, O_GLAS = 17563648, O_CONVP = 21757952, O_CONVS = 21848064, O_SGUV = 23289856;
constexpr size_t MiB = 1u << 20;
constexpr size_t WS_WIN = 0, WS_WOUT = WS_WIN + (size_t)NPROJ * D * 2, WS_WUP = WS_WOUT + (size_t)D * D * 2, WS_WDN = WS_WUP + (size_t)FF2 * D * 2,
                 WS_WPG = WS_WDN + (size_t)D * FF * 2, WS_WPLE = WS_WPG + (size_t)D * D * 2, WS_WEND = WS_WPLE + (size_t)D * PLE * 2;
constexpr size_t WS_H = 28 * MiB, WS_HALO = 61 * MiB, WS_BIG = 67 * MiB, WS_BIG2 = WS_BIG + 96 * MiB, WS_END = WS_BIG + (size_t)T * FF2 * 2;
static_assert(WS_WEND <= WS_H && WS_H + (size_t)T * D * 2 <= WS_HALO && WS_HALO + (size_t)264 * 2 * FF2 * 2 <= WS_BIG && WS_END <= 256 * MiB, "ws map");
static_assert(WS_BIG + (size_t)T * NPROJ * 2 <= WS_BIG2 && WS_BIG2 + (size_t)T * D * 4 <= WS_END, "ws map 2");
constexpr size_t WS_CTL = 255 * MiB, CTL_BYTES = 16384;
constexpr int LDS_BYTES = 135168, MISC_OFF = 131072;

__device__ __forceinline__ float bf2f(unsigned b) { return __uint_as_float(b << 16); }
__device__ __forceinline__ unsigned pk2(float lo, float hi) { unsigned r; asm("v_cvt_pk_bf16_f32 %0, %1, %2" : "=v"(r) : "v"(lo), "v"(hi)); return r; }
__device__ __forceinline__ float wave_sum(float v) {
#pragma unroll
    for (int o = 1; o < 64; o <<= 1) v += __shfl_xor(v, o);
    return v;
}
__device__ __forceinline__ float sigmoidf_(float x) { return __builtin_amdgcn_rcpf(1.f + __expf(-x)); }
__device__ __forceinline__ float gelu_t(float x) { return x * __builtin_amdgcn_rcpf(1.f + __expf(-1.5957691216057308f * (x + 0.044715f * x * x * x))); }
__device__ __forceinline__ float logsig(float x) { return fminf(x, 0.f) - __logf(1.f + __expf(-fabsf(x))); }
__device__ __forceinline__ float rdlane(float v, int l) { return __uint_as_float(__builtin_amdgcn_readlane(__float_as_uint(v), l)); }

namespace pg8 {
constexpr int BM = 256, BK = 64, HALF = 128, HTB = HALF * BK * 2, STAGE_BYTES = 8 * HTB, NXCD = 8, WGM = 8;
__device__ __forceinline__ int lds_byte(int r, int c) { const int st = (r >> 4) * 2 + (c >> 5), rr = r & 15, cc = c & 31, ob = rr * 64 + cc * 2; return st * 1024 + (ob ^ (((ob >> 9) & 1) << 5)); }
__device__ __forceinline__ void stage_rc(int b, int& R, int& C) { const int st = b / 1024, sb = b % 1024, swz = sb ^ (((sb >> 9) & 1) << 5); R = (st >> 1) * 16 + swz / 64; C = (st & 1) * 32 + (swz % 64) / 2; }
__device__ __forceinline__ int perm32(int rho) { const int n = rho >> 4, i = rho & 15; return 8 * (i >> 2) + 4 * n + (i & 3); }
struct Unit { int pm, pn, kt0, nkt, part; };
struct Gemm { const u16* A; const u16* Bt; int M, N, K, lda; };
struct StaticOrder {
    int nM, nN, nwg, G, c, nt, tail, split;
    __device__ void init(int M, int N, int K, int G_, int c_, int tail_, int split_) { tail = tail_; split = split_; nM = M / BM - tail; nN = N / BM; nwg = nM * nN; G = G_; c = c_; nt = K / BK; }
    __device__ bool next(int i, Unit& u) const {
        long L = (long)i * G + c;
        if (L < nwg) {
            int wgid = (int)L; { const int q = nwg / NXCD, r = nwg % NXCD, xcd = wgid % NXCD, off = wgid / NXCD; wgid = (xcd < r ? xcd * (q + 1) : r * (q + 1) + (xcd - r) * q) + off; }
            const int nig = WGM * nN, gid = wgid / nig, fm = gid * WGM, gsz = (nM - fm) < WGM ? (nM - fm) : WGM;
            u.pm = fm + ((wgid % nig) % gsz); u.pn = (wgid % nig) / gsz; u.kt0 = 0; u.nkt = nt; u.part = 0; return true;
        }
        L -= nwg; if (L >= (long)tail * nN * split) return false;
        const int ks = (int)L % split, tu = (int)L / split, pairs = nt / 2, base = pairs / split, ex = pairs % split;
        u.pm = nM + tu / nN; u.pn = tu % nN; u.kt0 = 2 * (ks * base + (ks < ex ? ks : ex)); u.nkt = 2 * (base + (ks < ex ? 1 : 0)); u.part = ks + 1; return true;
    }
};
struct EpiF32 {
    static constexpr bool PERM = false;
    float* C; int ldc; float* parts; int tail_row0; size_t slab;
    __device__ __forceinline__ void operator()(const f32x4 (&acc)[2][2][4][2], const Unit& u, int wr, int wc, int fr, int fq) const {
        const int row0 = u.pm * BM + wr * 64 + fr, col0 = u.pn * BM + wc * 32 + 4 * fq;
        float* base = u.part ? parts + (size_t)(u.part - 1) * slab - (size_t)tail_row0 * ldc : C;
#pragma unroll
        for (int ai = 0; ai < 2; ++ai)
#pragma unroll
            for (int m = 0; m < 4; ++m) { float* rowp = base + (size_t)(row0 + ai * HALF + m * 16) * ldc + col0;
#pragma unroll
                for (int bj = 0; bj < 2; ++bj)
#pragma unroll
                    for (int n = 0; n < 2; ++n) *(f32x4*)(rowp + bj * HALF + n * 16) = acc[ai][bj][m][n]; }
    }
};
struct EpiGateMul {
    static constexpr bool PERM = false;
    float* C; int ldc;
    __device__ __forceinline__ void operator()(const f32x4 (&acc)[2][2][4][2], const Unit& u, int wr, int wc, int fr, int fq) const {
        const int row0 = u.pm * BM + wr * 64 + fr, col0 = u.pn * BM + wc * 32 + 4 * fq;
#pragma unroll
        for (int ai = 0; ai < 2; ++ai)
#pragma unroll
            for (int m = 0; m < 4; ++m) { float* rowp = C + (size_t)(row0 + ai * HALF + m * 16) * ldc + col0;
#pragma unroll
                for (int bj = 0; bj < 2; ++bj)
#pragma unroll
                    for (int n = 0; n < 2; ++n) { f32x4 c = *(f32x4*)(rowp + bj * HALF + n * 16); const f32x4 a = acc[ai][bj][m][n];
                        c.x *= sigmoidf_(a.x); c.y *= sigmoidf_(a.y); c.z *= sigmoidf_(a.z); c.w *= sigmoidf_(a.w);
                        *(f32x4*)(rowp + bj * HALF + n * 16) = c; } }
    }
};
struct EpiBf16 {
    static constexpr bool PERM = true;
    u16* O; int ldc; u16* halo; float* tailacc; int tail_row0; size_t slab; int tail_ld; int gelu_from; int silu_from, silu_to;
    __device__ __forceinline__ void operator()(const f32x4 (&acc)[2][2][4][2], const Unit& u, int wr, int wc, int fr, int fq) const {
        const int row0 = u.pm * BM + wr * 64 + fr, col0 = u.pn * BM + wc * 32 + 8 * fq;
        if (u.part) {
            float* base = tailacc + (size_t)(u.part - 1) * slab - (size_t)tail_row0 * tail_ld;
#pragma unroll
            for (int ai = 0; ai < 2; ++ai)
#pragma unroll
                for (int m = 0; m < 4; ++m) { float* rowp = base + (size_t)(row0 + ai * HALF + m * 16) * tail_ld + col0;
#pragma unroll
                    for (int bj = 0; bj < 2; ++bj)
#pragma unroll
                        for (int n = 0; n < 2; ++n) *(f32x4*)(rowp + bj * HALF + 4 * n) = acc[ai][bj][m][n]; }
            return;
        }
#pragma unroll
        for (int ai = 0; ai < 2; ++ai)
#pragma unroll
            for (int m = 0; m < 4; ++m) { const int row = row0 + ai * HALF + m * 16; u16* rowp = O + (size_t)row * ldc + col0;
#pragma unroll
                for (int bj = 0; bj < 2; ++bj) { f32x4 v0 = acc[ai][bj][m][0], v1 = acc[ai][bj][m][1];
                    if (col0 + bj * HALF >= gelu_from) { v0 = (f32x4){gelu_t(v0.x), gelu_t(v0.y), gelu_t(v0.z), gelu_t(v0.w)}; v1 = (f32x4){gelu_t(v1.x), gelu_t(v1.y), gelu_t(v1.z), gelu_t(v1.w)}; }
                    else if (col0 + bj * HALF >= silu_from && col0 + bj * HALF < silu_to) { v0 = (f32x4){v0.x * sigmoidf_(v0.x), v0.y * sigmoidf_(v0.y), v0.z * sigmoidf_(v0.z), v0.w * sigmoidf_(v0.w)}; v1 = (f32x4){v1.x * sigmoidf_(v1.x), v1.y * sigmoidf_(v1.y), v1.z * sigmoidf_(v1.z), v1.w * sigmoidf_(v1.w)}; }
                    u32x4 w; w.x = pk2(v0[0], v0[1]); w.y = pk2(v0[2], v0[3]); w.z = pk2(v1[0], v1[1]); w.w = pk2(v1[2], v1[3]);
                    *(u32x4*)(rowp + bj * HALF) = w;
                    if (halo != nullptr && m == 3 && fr >= 14) *(u32x4*)(halo + (size_t)((row >> 6) * 2 + (fr - 14)) * ldc + col0 + bj * HALF) = w; } }
    }
};

template <class Epi>
__device__ __forceinline__ void gemm_phase(LAS unsigned char* lds, const Gemm g, const StaticOrder& S, const Epi& E) {
    const int tid = threadIdx.x, wid = __builtin_amdgcn_readfirstlane(tid >> 6), lane = tid & 63, wr = wid >> 2, wc = wid & 3, fr = lane & 15, fq = lane >> 4;
    const int K = g.K, lda = g.lda;
    unsigned voffA[2], voffB[2];
#pragma unroll
    for (int i = 0; i < 2; ++i) { int R, C; stage_rc(tid * 16 + i * 8192, R, C); const int Rb = Epi::PERM ? ((R & ~31) + perm32(R & 31)) : R;
        voffA[i] = (unsigned)(R * lda + C) * 2u; voffB[i] = (unsigned)(Rb * K + C) * 2u; }
    const size_t kstep = (size_t)(BK * 2);
    const size_t hstepA = (size_t)HALF * lda * 2, hstepB = (size_t)HALF * K * 2;
    const size_t tstepA = 2 * hstepA, tstepB = 2 * hstepB;
    const unsigned ldsw = (unsigned)wid * 1024u;
    const int aoff = lds_byte(wr * 64 + fr, fq * 8), boff = lds_byte(wc * 32 + fr, fq * 8);
#define PG8_SA(b, h) (((b) * 2 + (h)) * HTB)
#define PG8_SB(b, h) ((4 + (b) * 2 + (h)) * HTB)
#define PG8_STAGE(bufoff, gbase, voff) do { _Pragma("unroll") for (int _i = 0; _i < 2; ++_i) \
        __builtin_amdgcn_global_load_lds((const unsigned*)((const char*)(gbase) + (voff)[_i]), (LAS unsigned*)(lds + (bufoff) + ldsw + _i * 8192), 16, 0, 0); } while (0)
#define PG8_LDA(dst, b, h) do { _Pragma("unroll") for (int m = 0; m < 4; ++m) _Pragma("unroll") for (int k = 0; k < 2; ++k) dst[m][k] = *(const LAS bf16x8*)(lds + PG8_SA(b, h) + aoff + m * 2048 + k * 1024); } while (0)
#define PG8_LDB(dst, b, h) do { _Pragma("unroll") for (int n = 0; n < 2; ++n) _Pragma("unroll") for (int k = 0; k < 2; ++k) dst[n][k] = *(const LAS bf16x8*)(lds + PG8_SB(b, h) + boff + n * 2048 + k * 1024); } while (0)
#define PG8_MMA(ai, bj, At, Bt) do { __builtin_amdgcn_s_setprio(1); _Pragma("unroll") for (int m = 0; m < 4; ++m) _Pragma("unroll") for (int n = 0; n < 2; ++n) _Pragma("unroll") for (int k = 0; k < 2; ++k) \
        acc[ai][bj][m][n] = __builtin_amdgcn_mfma_f32_16x16x32_bf16(Bt[n][k], At[m][k], acc[ai][bj][m][n], 0, 0, 0); __builtin_amdgcn_s_setprio(0); } while (0)
#define PG8_WAIT_V(n) asm volatile("s_waitcnt vmcnt(" #n ")" ::: "memory")
#define PG8_WAIT_L(n) asm volatile("s_waitcnt lgkmcnt(" #n ")" ::: "memory")
#define PG8_BAR __builtin_amdgcn_s_barrier()
#define PG8_SCHED __builtin_amdgcn_sched_barrier(0)
    Unit cur, nxt; int ui = 0;
    if (!S.next(0, cur)) return;
    f32x4 acc[2][2][4][2];
#pragma unroll
    for (int a = 0; a < 2; ++a)
#pragma unroll
        for (int b = 0; b < 2; ++b)
#pragma unroll
            for (int m = 0; m < 4; ++m)
#pragma unroll
                for (int n = 0; n < 2; ++n) acc[a][b][m][n] = (f32x4){0.f, 0.f, 0.f, 0.f};
    bf16x8 At[4][2], B0[2][2], B1[2][2];
    const char* cA = (const char*)g.A + (size_t)cur.pm * tstepA + (size_t)cur.kt0 * kstep; const char* cB = (const char*)g.Bt + (size_t)cur.pn * tstepB + (size_t)cur.kt0 * kstep;
    PG8_STAGE(PG8_SB(0, 0), cB, voffB); PG8_STAGE(PG8_SA(0, 0), cA, voffA); PG8_STAGE(PG8_SB(0, 1), cB + hstepB, voffB); PG8_STAGE(PG8_SA(0, 1), cA + hstepA, voffA);
    if (wr == 1) PG8_BAR;
    PG8_WAIT_V(4); PG8_BAR;
    PG8_STAGE(PG8_SB(1, 0), cB + kstep, voffB); PG8_STAGE(PG8_SA(1, 0), cA + kstep, voffA); PG8_STAGE(PG8_SB(1, 1), cB + hstepB + kstep, voffB);
    PG8_WAIT_V(6); PG8_BAR;
    for (;;) {
        const bool has_next = S.next(ui + 1, nxt);
        const char* nA = has_next ? (const char*)g.A + (size_t)nxt.pm * tstepA + (size_t)nxt.kt0 * kstep : cA; const char* nB = has_next ? (const char*)g.Bt + (size_t)nxt.pn * tstepB + (size_t)nxt.kt0 * kstep : cB;
        const int nt = cur.nkt;
        for (int t = 0; t < nt; t += 2) {
            const bool last = (t == nt - 2);
            const char* a1 = cA + (size_t)(t + 1) * kstep;
            const char* a2 = last ? nA : cA + (size_t)(t + 2) * kstep; const char* b2 = last ? nB : cB + (size_t)(t + 2) * kstep;
            const char* a3 = a2 + kstep; const char* b3 = b2 + kstep;
            PG8_LDB(B0, 0, 0); PG8_SCHED; PG8_LDA(At, 0, 0); PG8_STAGE(PG8_SA(1, 1), a1 + hstepA, voffA);
            PG8_WAIT_L(8); PG8_BAR; PG8_WAIT_L(0); PG8_MMA(0, 0, At, B0); PG8_BAR; PG8_SCHED;
            PG8_LDB(B1, 0, 1); PG8_STAGE(PG8_SB(0, 0), b2, voffB);
            PG8_BAR; PG8_WAIT_L(0); PG8_MMA(0, 1, At, B1); PG8_BAR;
            PG8_LDA(At, 0, 1); PG8_STAGE(PG8_SA(0, 0), a2, voffA);
            PG8_BAR; PG8_WAIT_L(0); PG8_MMA(1, 0, At, B0); PG8_BAR; PG8_SCHED;
            PG8_STAGE(PG8_SB(0, 1), b2 + hstepB, voffB);
            PG8_WAIT_V(6); PG8_BAR; PG8_MMA(1, 1, At, B1); PG8_BAR;
            PG8_LDB(B0, 1, 0); PG8_SCHED; PG8_LDA(At, 1, 0); PG8_STAGE(PG8_SA(0, 1), a2 + hstepA, voffA);
            PG8_WAIT_L(8); PG8_BAR; PG8_WAIT_L(0); PG8_MMA(0, 0, At, B0); PG8_BAR; PG8_SCHED;
            PG8_LDB(B1, 1, 1); PG8_STAGE(PG8_SB(1, 0), b3, voffB);
            PG8_BAR; PG8_WAIT_L(0); PG8_MMA(0, 1, At, B1); PG8_BAR;
            PG8_LDA(At, 1, 1); PG8_STAGE(PG8_SA(1, 0), a3, voffA);
            PG8_BAR; PG8_WAIT_L(0); PG8_MMA(1, 0, At, B0); PG8_BAR; PG8_SCHED;
            PG8_STAGE(PG8_SB(1, 1), b3 + hstepB, voffB);
            PG8_WAIT_V(6); PG8_BAR; PG8_MMA(1, 1, At, B1); PG8_BAR;
        }
        E(acc, cur, wr, wc, fr, fq);
        if (!has_next) break;
#pragma unroll
        for (int a = 0; a < 2; ++a)
#pragma unroll
            for (int b = 0; b < 2; ++b)
#pragma unroll
                for (int m = 0; m < 4; ++m)
#pragma unroll
                    for (int n = 0; n < 2; ++n) acc[a][b][m][n] = (f32x4){0.f, 0.f, 0.f, 0.f};
        cur = nxt; cA = nA; cB = nB; ++ui;
    }
    PG8_WAIT_V(0);
    if (wr == 0) PG8_BAR;
    PG8_BAR;
#undef PG8_SA
#undef PG8_SB
#undef PG8_STAGE
#undef PG8_LDA
#undef PG8_LDB
#undef PG8_MMA
#undef PG8_WAIT_V
#undef PG8_WAIT_L
#undef PG8_BAR
#undef PG8_SCHED
}
}


#define XB_TMO      128
#define XB_XCNT(j)  (256  + 64 * (j))
#define XB_XSUB(j)  (1280 + 64 * (j))
#define XB_XGEN(j)  (2304 + 64 * (j))
#define XB_TOP      3328
#define XB_TOPGEN   3392
#define XCD_BAR_WORDS 3456
#define XB_SPIN_CAP (1u << 22)
__device__ __forceinline__ unsigned xb_ld(unsigned* p)              { return __hip_atomic_load(p, __ATOMIC_RELAXED, __HIP_MEMORY_SCOPE_AGENT); }
__device__ __forceinline__ unsigned xb_add(unsigned* p, unsigned v) { return __hip_atomic_fetch_add(p, v, __ATOMIC_RELAXED, __HIP_MEMORY_SCOPE_AGENT); }
__device__ __forceinline__ unsigned xb_xcc_id() { return (unsigned)__builtin_amdgcn_s_getreg((3 << 11) | 20) & 0xFu; }
#define XB_SPIN(cond, bar) do { unsigned _sp = 0; while (cond) { __builtin_amdgcn_s_sleep(1); \
    if ((++_sp & 255u) == 0u) { if (xb_ld(&(bar)[XB_TMO])) break; if (_sp > XB_SPIN_CAP) { atomicAdd(&(bar)[XB_TMO], 1u); break; } } } } while (0)
struct XcdBarrier { unsigned* bar; unsigned x; volatile LAS unsigned* st; };
__device__ __forceinline__ XcdBarrier xcd_barrier_post(unsigned* bar, volatile LAS unsigned* st) {
    XcdBarrier b; b.bar = bar; b.x = xb_xcc_id(); b.st = st;
    if (threadIdx.x == 0) (void)xb_add(&bar[XB_XCNT(b.x)], 1u);
    return b;
}
__device__ __forceinline__ void xcd_barrier_complete(unsigned* bar, unsigned x, unsigned& nloc, unsigned& nx) {
    const unsigned G = gridDim.x * gridDim.y * gridDim.z;
    unsigned sum, cnt, mine, sp = 0u;
    for (;;) {
        sum = 0u; cnt = 0u; mine = 0u;
#pragma unroll
        for (unsigned j = 0; j < 16; ++j) { const unsigned c = xb_ld(&bar[XB_XCNT(j)]); sum += c; cnt += (c > 0u) ? 1u : 0u; mine = (j == x) ? c : mine; }
        if (sum == G) break;
        __builtin_amdgcn_s_sleep(1);
        if ((++sp & 255u) == 0u) { if (xb_ld(&bar[XB_TMO])) break; if (sp > XB_SPIN_CAP) { atomicAdd(&bar[XB_TMO], 1u); break; } }
    }
    nloc = mine > 0u ? mine : 1u; nx = cnt > 0u ? cnt : 1u;
}
__device__ __forceinline__ void xcd_barrier(const XcdBarrier& b) {
    asm volatile("s_waitcnt vmcnt(0)" ::: "memory");
    __syncthreads();
    if (threadIdx.x == 0) {
        unsigned* bar = b.bar;
        __builtin_amdgcn_s_waitcnt(0);
        unsigned nloc = b.st[0], nx = b.st[1];
        if (nloc == 0u) { xcd_barrier_complete(bar, b.x, nloc, nx); b.st[0] = nloc; b.st[1] = nx; }
        const unsigned old = xb_add(&bar[XB_XSUB(b.x)], 1u);
        const unsigned gen = old / nloc;
        if (old + 1u == (gen + 1u) * nloc) {
            __builtin_amdgcn_fence(__ATOMIC_RELEASE, "agent");
            asm volatile("s_waitcnt vmcnt(0)" ::: "memory");
            const unsigned og = xb_add(&bar[XB_TOP], 1u);
            const unsigned tg = og / nx;
            if (og + 1u == (tg + 1u) * nx) xb_add(&bar[XB_TOPGEN], 1u);
            else XB_SPIN(xb_ld(&bar[XB_TOPGEN]) == tg, bar);
            __builtin_amdgcn_fence(__ATOMIC_ACQUIRE, "agent");
            xb_add(&bar[XB_XGEN(b.x)], 1u);
            asm volatile("s_waitcnt vmcnt(0)" ::: "memory");
        } else {
            XB_SPIN(xb_ld(&bar[XB_XGEN(b.x)]) == gen, bar);
            __builtin_amdgcn_fence(__ATOMIC_ACQUIRE, "agent");
            asm volatile("s_waitcnt vmcnt(0)" ::: "memory");
        }
    }
    __syncthreads();
}

struct Args {
    const float* in[27];
    float* out; unsigned char* ws;
    int ph_lo, ph_hi;
};
enum { I_XP = 0, I_XS, I_SGLA, I_SCONV, I_PP, I_PS, I_GMIXPRE, I_WIN, I_WGATE, I_BGATE, I_GGLAOUT, I_GSGULN, I_BSGULN, I_WSPAT, I_BSPAT, I_WOUT, I_GMIXPOST,
       I_GFFNPRE, I_WUP, I_WCONV, I_BCONV, I_WDOWN, I_GFFNPOST, I_GPLEIN, I_WPG, I_WPLE, I_GPLEPOST };

__device__ __forceinline__ void transpose_tile(const float* W, int K, int N, u16* WT, int k0, int n0, LAS float* scr, int tid) {
#pragma unroll
    for (int i = 0; i < 8; ++i) { const int k = i * 8 + (tid >> 6), n = tid & 63; scr[k * 65 + n] = (n0 + n < N) ? W[(size_t)(k0 + k) * N + n0 + n] : 0.f; }
    __syncthreads();
    const int n = tid >> 3, c = tid & 7; const LAS float* s = scr + (8 * c) * 65 + n;
    u32x4 o; o.x = pk2(s[0], s[65]); o.y = pk2(s[130], s[195]); o.z = pk2(s[260], s[325]); o.w = pk2(s[390], s[455]);
    *(u32x4*)(WT + (size_t)(n0 + n) * K + k0 + 8 * c) = o;
    __syncthreads();
}

constexpr int NR = 3;
struct RowPtrs { const float* srcf; const u16* srcb; const void* resid; void* xout; u16* hout; bool parts4; };
template <int RB, int XB>
__device__ __forceinline__ void row_op2(const RowPtrs (&r)[NR], bool has_src, const float* gpost, const float* gnext, int lane) {
    f32x4 x[NR][4], s[NR][4];
#pragma unroll
    for (int k = 0; k < NR; ++k)
#pragma unroll
        for (int j = 0; j < 4; ++j) {
            if (RB) { const u32x2 wv = ((const u32x2*)r[k].resid)[lane + 64 * j]; x[k][j] = (f32x4){bf2f(wv.x & 0xffffu), bf2f(wv.x >> 16), bf2f(wv.y & 0xffffu), bf2f(wv.y >> 16)}; }
            else x[k][j] = ((const f32x4*)r[k].resid)[lane + 64 * j]; }
    if (has_src) {
        u32x2 sb[NR][4];
#pragma unroll
        for (int k = 0; k < NR; ++k)
#pragma unroll
            for (int j = 0; j < 4; ++j) {
                if (r[k].srcf != nullptr) { const float* sf = r[k].srcf; s[k][j] = ((const f32x4*)sf)[lane + 64 * j];
                    if (r[k].parts4) s[k][j] = (s[k][j] + ((const f32x4*)(sf + (size_t)TS * D))[lane + 64 * j]) + (((const f32x4*)(sf + (size_t)2 * TS * D))[lane + 64 * j] + ((const f32x4*)(sf + (size_t)3 * TS * D))[lane + 64 * j]); }
                else sb[k][j] = ((const u32x2*)r[k].srcb)[lane + 64 * j];
            }
        float ss[NR];
#pragma unroll
        for (int k = 0; k < NR; ++k) { ss[k] = 0.f;
#pragma unroll
            for (int j = 0; j < 4; ++j) {
                if (r[k].srcf == nullptr) { const u32x2 w = sb[k][j]; s[k][j] = (f32x4){bf2f(w.x & 0xffffu), bf2f(w.x >> 16), bf2f(w.y & 0xffffu), bf2f(w.y >> 16)}; }
                ss[k] += (s[k][j].x * s[k][j].x + s[k][j].y * s[k][j].y) + (s[k][j].z * s[k][j].z + s[k][j].w * s[k][j].w); } }
#pragma unroll
        for (int o = 1; o < 64; o <<= 1) {
#pragma unroll
            for (int k = 0; k < NR; ++k) ss[k] += __shfl_xor(ss[k], o); }
#pragma unroll
        for (int k = 0; k < NR; ++k) { const float rs = rsqrtf(ss[k] * (1.f / D) + EPS);
#pragma unroll
            for (int j = 0; j < 4; ++j) { const f32x4 g = ((const f32x4*)gpost)[lane + 64 * j]; x[k][j] = x[k][j] + s[k][j] * rs * g; } }
    }
#pragma unroll
    for (int k = 0; k < NR; ++k)
        if (r[k].xout != nullptr) {
#pragma unroll
            for (int j = 0; j < 4; ++j) {
                if (XB) { u32x2 wv; wv.x = pk2(x[k][j].x, x[k][j].y); wv.y = pk2(x[k][j].z, x[k][j].w); ((u32x2*)r[k].xout)[lane + 64 * j] = wv; }
                else ((f32x4*)r[k].xout)[lane + 64 * j] = x[k][j]; }
        }
    if (gnext != nullptr) {
        float ss[NR];
#pragma unroll
        for (int k = 0; k < NR; ++k) { ss[k] = 0.f;
#pragma unroll
            for (int j = 0; j < 4; ++j) ss[k] += (x[k][j].x * x[k][j].x + x[k][j].y * x[k][j].y) + (x[k][j].z * x[k][j].z + x[k][j].w * x[k][j].w); }
#pragma unroll
        for (int o = 1; o < 64; o <<= 1) {
#pragma unroll
            for (int k = 0; k < NR; ++k) ss[k] += __shfl_xor(ss[k], o); }
#pragma unroll
        for (int k = 0; k < NR; ++k) { const float rs = rsqrtf(ss[k] * (1.f / D) + EPS);
#pragma unroll
            for (int j = 0; j < 4; ++j) { const f32x4 g = ((const f32x4*)gnext)[lane + 64 * j]; const f32x4 h = x[k][j] * rs * g;
                u32x2 w; w.x = pk2(h.x, h.y); w.y = pk2(h.z, h.w); ((u32x2*)r[k].hout)[lane + 64 * j] = w; } }
    }
}

struct FinPtrs { const u16* peb; const u16* glb; const float* pes; const float* gls; const u16* xin; float* yout; };
__device__ __forceinline__ void row_final2(const FinPtrs (&r)[NR], const float* g, int lane) {
    f32x4 z[NR][4], x[NR][4]; u32x2 ra[NR][4], rb[NR][4]; float ss[NR];
#pragma unroll
    for (int k = 0; k < NR; ++k)
#pragma unroll
        for (int j = 0; j < 4; ++j) { { const u32x2 wv = ((const u32x2*)r[k].xin)[lane + 64 * j]; x[k][j] = (f32x4){bf2f(wv.x & 0xffffu), bf2f(wv.x >> 16), bf2f(wv.y & 0xffffu), bf2f(wv.y >> 16)}; }
            ra[k][j] = ((const u32x2*)r[k].peb)[lane + 64 * j]; if (r[k].gls == nullptr) rb[k][j] = ((const u32x2*)r[k].glb)[lane + 64 * j]; }
#pragma unroll
    for (int k = 0; k < NR; ++k) { ss[k] = 0.f;
#pragma unroll
        for (int j = 0; j < 4; ++j) {
            f32x4 pe, gl;
            { const u32x2 a = ra[k][j]; pe = (f32x4){bf2f(a.x & 0xffffu), bf2f(a.x >> 16), bf2f(a.y & 0xffffu), bf2f(a.y >> 16)}; }
            if (r[k].gls == nullptr) { const u32x2 b = rb[k][j]; gl = (f32x4){bf2f(b.x & 0xffffu), bf2f(b.x >> 16), bf2f(b.y & 0xffffu), bf2f(b.y >> 16)}; }
            else { const float* gls = r[k].gls;
                gl = (((const f32x4*)gls)[lane + 64 * j] + ((const f32x4*)(gls + (size_t)TS * D))[lane + 64 * j]) + (((const f32x4*)(gls + (size_t)2 * TS * D))[lane + 64 * j] + ((const f32x4*)(gls + (size_t)3 * TS * D))[lane + 64 * j]); }
            z[k][j] = (f32x4){pe.x * sigmoidf_(gl.x), pe.y * sigmoidf_(gl.y), pe.z * sigmoidf_(gl.z), pe.w * sigmoidf_(gl.w)};
            ss[k] += (z[k][j].x * z[k][j].x + z[k][j].y * z[k][j].y) + (z[k][j].z * z[k][j].z + z[k][j].w * z[k][j].w);
        } }
#pragma unroll
    for (int o = 1; o < 64; o <<= 1) {
#pragma unroll
            for (int k = 0; k < NR; ++k) ss[k] += __shfl_xor(ss[k], o); }
#pragma unroll
    for (int k = 0; k < NR; ++k) { const float rs = rsqrtf(ss[k] * (1.f / D) + EPS);
#pragma unroll
        for (int j = 0; j < 4; ++j) { const f32x4 gv = ((const f32x4*)g)[lane + 64 * j]; ((f32x4*)r[k].yout)[lane + 64 * j] = x[k][j] + z[k][j] * rs * gv; } }
}

#define LBAR() do { asm volatile("s_waitcnt lgkmcnt(0)" ::: "memory"); __builtin_amdgcn_s_barrier(); asm volatile("" ::: "memory"); } while (0)

constexpr int LD = 72;
__device__ __forceinline__ bf16x8 frag(const LAS u16* arr, int row0, int ld, int k0, int lane) { return *(const LAS bf16x8*)(arr + (row0 + (lane & 15)) * ld + k0 + (lane >> 4) * 8); }
__device__ __forceinline__ f32x4 mma16(bf16x8 a, bf16x8 b, f32x4 c) { return __builtin_amdgcn_mfma_f32_16x16x32_bf16(a, b, c, 0, 0, 0); }

struct GateW { float wg[16]; float bgd; int h; };
constexpr int RP = 132;
__device__ __forceinline__ bf16x8 gfrag(const LAS u16* arr, int pitch, int k0, int col, int lane) {
    const LAS u16* p = arr + (k0 + (lane >> 4) * 8) * pitch + col;
    bf16x8 r;
#pragma unroll
    for (int j = 0; j < 8; ++j) r[j] = (short)p[j * pitch];
    return r;
}
template <int MODE>
__device__ __forceinline__ void gla_chunk_item(int item, const u16* PROJ, u16* MIXIN, const float* wgate, const float* bgate, const float* ggla, float* GS, float* GDEC, const u16* GSB, LAS unsigned char* lds, GateW& gw_) {
    const int tid = threadIdx.x, lane = tid & 63, w = __builtin_amdgcn_readfirstlane(tid >> 6);
    const int nh = item >> 5, c = item & 31, n = nh >> 2, h = nh & 3;
    LAS u16* Qt = (LAS u16*)lds;
    LAS u16* Kt = Qt + 64 * LD;
    LAS u16* KdT = Kt + 64 * LD;
    LAS u16* Pm = KdT + 64 * LD;
    LAS u16* RQ = Pm + 64 * LD;
    LAS u16* RK = RQ + 64 * 64;
    LAS u16* RV = RK + 64 * 64;
    LAS u16* SN = RV + 64 * RP;
    LAS float* GLR = (LAS float*)(SN + 64 * RP);
    LAS float* SEG = GLR + 64 * 16;
    LAS float* SSQ = SEG + 8 * 64;
    const int d = lane, seg = w;
    const size_t row0 = (size_t)n * 2048 + c * 64;
    float* gs = GS + (size_t)item * 8192;
    if (h != gw_.h) {
#pragma unroll
        for (int r = 0; r < 16; ++r) gw_.wg[r] = wgate[r * 256 + h * 64 + d];
        gw_.bgd = bgate[h * 64 + d]; gw_.h = h;
    }
    const int qt_ = tid >> 3, qd_ = (tid & 7) * 8;
    const int vt_ = tid >> 4, ve_ = (tid & 15) * 8;
    u32x4 qraw, kraw, vraw0, vraw1, sraw[2];
    if (MODE == 1) qraw = *(const u32x4*)(PROJ + (row0 + qt_) * NPROJ + C_Q + h * 64 + qd_);
    kraw = *(const u32x4*)(PROJ + (row0 + qt_) * NPROJ + C_K + h * 64 + qd_);
    vraw0 = *(const u32x4*)(PROJ + (row0 + vt_) * NPROJ + C_V + h * 128 + ve_);
    vraw1 = *(const u32x4*)(PROJ + (row0 + 32 + vt_) * NPROJ + C_V + h * 128 + ve_);
    const unsigned glr = *(const unsigned*)(PROJ + (row0 + seg * 8 + (lane >> 3)) * NPROJ + C_GLR + (lane & 7) * 2);
    if (MODE == 1) {
#pragma unroll
        for (int i = 0; i < 2; ++i) sraw[i] = ((const u32x4*)(GSB + (size_t)item * 8192))[tid + 512 * i];
    }
    GLR[(seg * 8 + (lane >> 3)) * 16 + (lane & 7) * 2] = bf2f(glr & 0xffffu);
    GLR[(seg * 8 + (lane >> 3)) * 16 + (lane & 7) * 2 + 1] = bf2f(glr >> 16);
    float bl[8], run = 0.f;
#pragma unroll
    for (int tt = 0; tt < 8; ++tt) {
        const LAS f32x4* gp = (const LAS f32x4*)(GLR + (seg * 8 + tt) * 16);
        float logit = gw_.bgd;
#pragma unroll
        for (int r4 = 0; r4 < 4; ++r4) { const f32x4 gv = gp[r4]; logit += gv.x * gw_.wg[4 * r4] + gv.y * gw_.wg[4 * r4 + 1] + gv.z * gw_.wg[4 * r4 + 2] + gv.w * gw_.wg[4 * r4 + 3]; }
        run += logsig(logit) * (1.f / 16.f); bl[tt] = run;
    }
    SEG[seg * 64 + d] = run;
    if (MODE == 1) *(LAS u32x4*)(RQ + qt_ * 64 + qd_) = qraw;
    *(LAS u32x4*)(RK + qt_ * 64 + qd_) = kraw;
    *(LAS u32x2*)(RV + vt_ * RP + ve_) = (u32x2){vraw0.x, vraw0.y}; *(LAS u32x2*)(RV + vt_ * RP + ve_ + 4) = (u32x2){vraw0.z, vraw0.w};
    *(LAS u32x2*)(RV + (32 + vt_) * RP + ve_) = (u32x2){vraw1.x, vraw1.y}; *(LAS u32x2*)(RV + (32 + vt_) * RP + ve_ + 4) = (u32x2){vraw1.z, vraw1.w};
    if (MODE == 1) {
#pragma unroll
        for (int i = 0; i < 2; ++i) { const int idx = tid + 512 * i; LAS u16* sp_ = SN + (idx >> 4) * RP + (idx & 15) * 8;
            *(LAS u32x2*)sp_ = (u32x2){sraw[i].x, sraw[i].y}; *(LAS u32x2*)(sp_ + 4) = (u32x2){sraw[i].z, sraw[i].w}; }
    }
    LBAR();
    float off = 0.f, tot = 0.f;
#pragma unroll
    for (int s = 0; s < 8; ++s) { const float v = SEG[s * 64 + d]; tot += v; off += (s < seg) ? v : 0.f; }
    if (MODE == 0) {
        float kd[8];
#pragma unroll
        for (int tt = 0; tt < 8; ++tt) kd[tt] = bf2f(RK[(seg * 8 + tt) * 64 + d]) * __expf(tot - (off + bl[tt]));
        u32x4 kk; kk.x = pk2(kd[0], kd[1]); kk.y = pk2(kd[2], kd[3]); kk.z = pk2(kd[4], kd[5]); kk.w = pk2(kd[6], kd[7]);
        *(LAS u32x4*)(KdT + d * LD + seg * 8) = kk;
        if (seg == 0) GDEC[(size_t)item * 64 + d] = __expf(tot);
        LBAR();
        const bf16x8 av0 = gfrag(RV, RP, 0, 16 * w + (lane & 15), lane), av1 = gfrag(RV, RP, 32, 16 * w + (lane & 15), lane);
#pragma unroll
        for (int dt = 0; dt < 4; ++dt) { f32x4 s = (f32x4){0.f, 0.f, 0.f, 0.f};
            s = mma16(av0, frag(KdT, dt * 16, LD, 0, lane), s); s = mma16(av1, frag(KdT, dt * 16, LD, 32, lane), s);
            *(f32x4*)(gs + (size_t)(16 * dt + (lane & 15)) * 128 + 16 * w + (lane >> 4) * 4) = s; }
        LBAR();
    } else {
#pragma unroll
        for (int tt = 0; tt < 8; ++tt) {
            const int i = seg * 8 + tt;
            const float b = off + bl[tt], q = bf2f(RQ[i * 64 + d]), k = bf2f(RK[i * 64 + d]);
            const float qv = q * 0.125f * __expf(b), kv = k * __expf(-b);
            Qt[i * LD + d] = (u16)(pk2(qv, 0.f) & 0xffffu); Kt[i * LD + d] = (u16)(pk2(kv, 0.f) & 0xffffu);
        }
        const int e4 = 16 * w + (lane >> 4) * 4;
        const f32x4 gg = *(const f32x4*)(ggla + e4);
        u32x2 rw[4];
#pragma unroll
        for (int it = 0; it < 4; ++it) rw[it] = *(const u32x2*)(PROJ + (row0 + it * 16 + (lane & 15)) * NPROJ + C_R + h * 128 + e4);
        LBAR();
        {
            const int it = w >> 1; const bf16x8 bq0 = frag(Qt, it * 16, LD, 0, lane), bq1 = frag(Qt, it * 16, LD, 32, lane);
#pragma unroll
            for (int jj = 0; jj < 2; ++jj) { const int jt = 2 * (w & 1) + jj;
                f32x4 p = (f32x4){0.f, 0.f, 0.f, 0.f};
                p = mma16(frag(Kt, jt * 16, LD, 0, lane), bq0, p); p = mma16(frag(Kt, jt * 16, LD, 32, lane), bq1, p);
                const int i = it * 16 + (lane & 15), j0 = jt * 16 + (lane >> 4) * 4;
                u32x2 pv; pv.x = pk2(j0 <= i ? p.x : 0.f, j0 + 1 <= i ? p.y : 0.f); pv.y = pk2(j0 + 2 <= i ? p.z : 0.f, j0 + 3 <= i ? p.w : 0.f);
                *(LAS u32x2*)(Pm + i * LD + j0) = pv; }
        }
        LBAR();
        f32x4 o[4];
        {
            const int ec = 16 * w + (lane & 15);
            const bf16x8 as0 = gfrag(SN, RP, 0, ec, lane), as1 = gfrag(SN, RP, 32, ec, lane), av0 = gfrag(RV, RP, 0, ec, lane), av1 = gfrag(RV, RP, 32, ec, lane);
#pragma unroll
            for (int it = 0; it < 4; ++it) { f32x4 a = (f32x4){0.f, 0.f, 0.f, 0.f};
                a = mma16(as0, frag(Qt, it * 16, LD, 0, lane), a); a = mma16(as1, frag(Qt, it * 16, LD, 32, lane), a);
                a = mma16(av0, frag(Pm, it * 16, LD, 0, lane), a); a = mma16(av1, frag(Pm, it * 16, LD, 32, lane), a); o[it] = a; }
        }
#pragma unroll
        for (int it = 0; it < 4; ++it) { float s = o[it].x * o[it].x + o[it].y * o[it].y + o[it].z * o[it].z + o[it].w * o[it].w;
            s += __shfl_xor(s, 16); s += __shfl_xor(s, 32);
            if (lane < 16) SSQ[(it * 16 + lane) * 8 + w] = s; }
        LBAR();
#pragma unroll
        for (int it = 0; it < 4; ++it) { const int i = it * 16 + (lane & 15);
            const f32x4 s0 = *(const LAS f32x4*)(SSQ + i * 8), s1 = *(const LAS f32x4*)(SSQ + i * 8 + 4);
            const float rs = rsqrtf(((s0.x + s0.y) + (s0.z + s0.w) + (s1.x + s1.y) + (s1.z + s1.w)) * (1.f / 128.f) + EPS);
            const size_t row = row0 + i;
            const float r0 = bf2f(rw[it].x & 0xffffu), r1 = bf2f(rw[it].x >> 16), r2 = bf2f(rw[it].y & 0xffffu), r3 = bf2f(rw[it].y >> 16);
            u32x2 ov; ov.x = pk2(o[it].x * rs * gg.x * r0, o[it].y * rs * gg.y * r1);
            ov.y = pk2(o[it].z * rs * gg.z * r2, o[it].w * rs * gg.w * r3);
            *(u32x2*)(MIXIN + row * D + h * 128 + e4) = ov; }
        LBAR();
    }
}

__device__ __forceinline__ void gla_scan(int gid, const float* GS, u16* GSB, const float* GDEC, float* out_state) {
    const int nh = gid >> 12, rem = gid & 4095, d = rem >> 6, e2 = (rem & 63) * 2;
    const float* gp = GS + (size_t)nh * 32 * 8192 + d * 128 + e2;
    u16* bp = GSB + (size_t)nh * 32 * 8192 + d * 128 + e2;
    const float* dp = GDEC + (size_t)nh * 32 * 64 + d;
    f32x2 S = (f32x2){0.f, 0.f};
    {
        f32x2 ds[32]; float dc[32];
#pragma unroll
        for (int j = 0; j < 32; ++j) { ds[j] = *(const f32x2*)(gp + (size_t)j * 8192); dc[j] = dp[j * 64]; }
#pragma unroll
        for (int j = 0; j < 32; ++j) { *(unsigned*)(bp + (size_t)j * 8192) = pk2(S.x, S.y); S = S * dc[j] + ds[j]; }
    }
    *(f32x2*)(out_state + ((size_t)nh * 64 + d) * 128 + e2) = S;
}

constexpr int LD2 = 136;
__device__ __forceinline__ void sgu_prompt_item(int item, const u16* PROJ, u16* MIXIN, const float* gln, const float* bln, const float* wsp, const float* bsp, LAS unsigned char* lds, int& hh_cached) {
    const int tid = threadIdx.x, lane = tid & 63, w = __builtin_amdgcn_readfirstlane(tid >> 6);
    const int hh = item & 3, cc = (item >> 2) & 15, n = item >> 6;
    const size_t row0 = (size_t)n * 2048 + cc * 128;
    LAS u16* VnT = (LAS u16*)lds;
    LAS u16* Wm = VnT + 128 * LD2;
    LAS u16* RAW = Wm + 128 * LD2;
    LAS float* STAT = (LAS float*)(RAW + 128 * LD2);
    u32x4 rv[4];
#pragma unroll
    for (int i = 0; i < 4; ++i) { const int idx = tid + 512 * i, s = idx >> 4, ch = (idx & 15) * 8; rv[i] = *(const u32x4*)(PROJ + (row0 + s) * NPROJ + C_VS + hh * 128 + ch); }
    u32x2 uw[8];
#pragma unroll
    for (int dct = 0; dct < 8; ++dct) uw[dct] = *(const u32x2*)(PROJ + (row0 + 16 * w + (lane & 15)) * NPROJ + C_U + hh * 128 + 16 * dct + (lane >> 4) * 4);
    const float bs = bsp[hh * 128 + 16 * w + (lane & 15)];
    if (hh != hh_cached) {
        const int t = tid >> 2, s0 = (tid & 3) * 32; const float* wp = wsp + ((size_t)hh * 128 + t) * 128 + s0;
#pragma unroll
        for (int q = 0; q < 4; ++q) { const f32x4 a = *(const f32x4*)(wp + 8 * q), b = *(const f32x4*)(wp + 8 * q + 4); const int s = s0 + 8 * q;
            u32x4 o; o.x = pk2(s <= t ? a.x : 0.f, s + 1 <= t ? a.y : 0.f); o.y = pk2(s + 2 <= t ? a.z : 0.f, s + 3 <= t ? a.w : 0.f);
            o.z = pk2(s + 4 <= t ? b.x : 0.f, s + 5 <= t ? b.y : 0.f); o.w = pk2(s + 6 <= t ? b.z : 0.f, s + 7 <= t ? b.w : 0.f);
            *(LAS u32x4*)(Wm + t * LD2 + s) = o; }
        hh_cached = hh;
    }
#pragma unroll
    for (int i = 0; i < 4; ++i) { const int idx = tid + 512 * i, s = idx >> 4, ch = (idx & 15) * 8; *(LAS u32x4*)(RAW + s * LD2 + ch) = rv[i]; }
    LBAR();
    { const int s = tid >> 2, qd = tid & 3; float s1 = 0.f, s2 = 0.f;
#pragma unroll
      for (int i = 0; i < 4; ++i) { const u32x4 r = *(const LAS u32x4*)(RAW + s * LD2 + qd * 32 + 8 * i);
          const unsigned ww[4] = {r.x, r.y, r.z, r.w};
#pragma unroll
          for (int k = 0; k < 4; ++k) { const float a = bf2f(ww[k] & 0xffffu), b = bf2f(ww[k] >> 16); s1 += a + b; s2 += a * a + b * b; } }
      s1 += __shfl_xor(s1, 1); s2 += __shfl_xor(s2, 1); s1 += __shfl_xor(s1, 2); s2 += __shfl_xor(s2, 2);
      const float mu = s1 * (1.f / 128.f), var = fmaxf(s2 * (1.f / 128.f) - mu * mu, 0.f);
      if (qd == 0) { STAT[2 * s] = mu; STAT[2 * s + 1] = rsqrtf(var + EPS); } }
    LBAR();
    { const int dc = tid & 127, sg = tid >> 7; const float g = gln[hh * 128 + dc], b = bln[hh * 128 + dc];
#pragma unroll
      for (int i = 0; i < 4; ++i) { const int s0 = sg * 32 + i * 8; float v[8];
#pragma unroll
          for (int j = 0; j < 8; ++j) { const f32x2 st = *(const LAS f32x2*)(STAT + 2 * (s0 + j)); v[j] = (bf2f(RAW[(s0 + j) * LD2 + dc]) - st.x) * st.y * g + b; }
          u32x4 o; o.x = pk2(v[0], v[1]); o.y = pk2(v[2], v[3]); o.z = pk2(v[4], v[5]); o.w = pk2(v[6], v[7]);
          *(LAS u32x4*)(VnT + dc * LD2 + s0) = o; } }
    LBAR();
    f32x4 acc[8];
#pragma unroll
    for (int dct = 0; dct < 8; ++dct) acc[dct] = (f32x4){0.f, 0.f, 0.f, 0.f};
    for (int ks = 0; ks <= (w >> 1); ++ks) { const bf16x8 b = frag(Wm, 16 * w, LD2, ks * 32, lane);
#pragma unroll
        for (int dct = 0; dct < 8; ++dct) acc[dct] = mma16(frag(VnT, dct * 16, LD2, ks * 32, lane), b, acc[dct]); }
    { const int t = 16 * w + (lane & 15); const size_t row = row0 + t;
#pragma unroll
      for (int dct = 0; dct < 8; ++dct) { const int dc = 16 * dct + (lane >> 4) * 4;
          u32x2 ov; ov.x = pk2(bf2f(uw[dct].x & 0xffffu) * (acc[dct].x + bs), bf2f(uw[dct].x >> 16) * (acc[dct].y + bs));
          ov.y = pk2(bf2f(uw[dct].y & 0xffffu) * (acc[dct].z + bs), bf2f(uw[dct].y >> 16) * (acc[dct].w + bs));
          *(u32x2*)(MIXIN + row * D + 512 + hh * 128 + dc) = ov; } }
    LBAR();
}

__device__ __forceinline__ void gla_sample_item(int nh, const u16* PROJ, u16* MIXIN, const float* wgate, const float* bgate, const float* ggla, const float* state_in, float* state_out, LAS unsigned char* lds) {
    const int tid = threadIdx.x, lane = tid & 63, w = __builtin_amdgcn_readfirstlane(tid >> 6), n = nh >> 2, h = nh & 3;
    LAS float* AKQ = (LAS float*)lds;
    LAS float* PO = AKQ + 4 * 3 * 64;
    LAS float* SS = PO + 4 * 4 * 128;
    const int e = tid & 127, dq = w >> 1;
    float S[16];
    const float* sp = state_in + ((size_t)nh * 64 + dq * 16) * 128 + e;
#pragma unroll
    for (int i = 0; i < 16; ++i) S[i] = sp[i * 128];
    if (tid < 256) {
        const int t = tid >> 6, d = tid & 63;
        const u16* pr = PROJ + ((size_t)TP + n * 4 + t) * NPROJ;
        const u32x4 ga = *(const u32x4*)(pr + C_GLR), gb = *(const u32x4*)(pr + C_GLR + 8);
        const float* wgp = wgate + h * 64 + d;
        float logit = bgate[h * 64 + d];
        logit += bf2f(ga.x & 0xffffu) * wgp[0] + bf2f(ga.x >> 16) * wgp[256] + bf2f(ga.y & 0xffffu) * wgp[512] + bf2f(ga.y >> 16) * wgp[768];
        logit += bf2f(ga.z & 0xffffu) * wgp[1024] + bf2f(ga.z >> 16) * wgp[1280] + bf2f(ga.w & 0xffffu) * wgp[1536] + bf2f(ga.w >> 16) * wgp[1792];
        logit += bf2f(gb.x & 0xffffu) * wgp[2048] + bf2f(gb.x >> 16) * wgp[2304] + bf2f(gb.y & 0xffffu) * wgp[2560] + bf2f(gb.y >> 16) * wgp[2816];
        logit += bf2f(gb.z & 0xffffu) * wgp[3072] + bf2f(gb.z >> 16) * wgp[3328] + bf2f(gb.w & 0xffffu) * wgp[3584] + bf2f(gb.w >> 16) * wgp[3840];
        AKQ[(t * 3 + 0) * 64 + d] = __expf(logsig(logit) * (1.f / 16.f));
        AKQ[(t * 3 + 1) * 64 + d] = bf2f(pr[C_K + h * 64 + d]);
        AKQ[(t * 3 + 2) * 64 + d] = bf2f(pr[C_Q + h * 64 + d]) * 0.125f;
    }
    LBAR();
#pragma unroll
    for (int t = 0; t < 4; ++t) {
        const float v = bf2f(PROJ[((size_t)TP + n * 4 + t) * NPROJ + C_V + h * 128 + e]);
        float po = 0.f;
#pragma unroll
        for (int i4 = 0; i4 < 4; ++i4) {
            const f32x4 a = *(const LAS f32x4*)(AKQ + (t * 3 + 0) * 64 + dq * 16 + 4 * i4), k = *(const LAS f32x4*)(AKQ + (t * 3 + 1) * 64 + dq * 16 + 4 * i4), q = *(const LAS f32x4*)(AKQ + (t * 3 + 2) * 64 + dq * 16 + 4 * i4);
            S[4 * i4 + 0] = a.x * S[4 * i4 + 0] + k.x * v; po += q.x * S[4 * i4 + 0];
            S[4 * i4 + 1] = a.y * S[4 * i4 + 1] + k.y * v; po += q.y * S[4 * i4 + 1];
            S[4 * i4 + 2] = a.z * S[4 * i4 + 2] + k.z * v; po += q.z * S[4 * i4 + 2];
            S[4 * i4 + 3] = a.w * S[4 * i4 + 3] + k.w * v; po += q.w * S[4 * i4 + 3];
        }
        PO[(t * 4 + dq) * 128 + e] = po;
    }
    float* so = state_out + ((size_t)nh * 64 + dq * 16) * 128 + e;
#pragma unroll
    for (int i = 0; i < 16; ++i) so[i * 128] = S[i];
    LBAR();
    const int t2 = w >> 1, e2 = (w & 1) * 64 + lane;
    const float o = (PO[(t2 * 4 + 0) * 128 + e2] + PO[(t2 * 4 + 1) * 128 + e2]) + (PO[(t2 * 4 + 2) * 128 + e2] + PO[(t2 * 4 + 3) * 128 + e2]);
    const float part = wave_sum(o * o);
    if (lane == 0) SS[w] = part;
    LBAR();
    const float rs = rsqrtf((SS[2 * t2] + SS[2 * t2 + 1]) * (1.f / 128.f) + EPS);
    const size_t row = (size_t)TP + n * 4 + t2;
    const float r = bf2f(PROJ[row * NPROJ + C_R + h * 128 + e2]);
    MIXIN[row * D + h * 128 + e2] = (u16)(pk2(o * rs * ggla[e2] * r, 0.f) & 0xffffu);
    LBAR();
}

__device__ __forceinline__ void sgu_sample_item(int item, const u16* PROJ, u16* MIXIN, const float* gln, const float* bln, const float* wsp, const float* bsp, float* vout, int lane) {
    const int n = item >> 2, hh = item & 3; const int c0 = hh * 128 + 2 * lane;
    const float g0 = gln[c0], g1 = gln[c0 + 1], b0 = bln[c0], b1 = bln[c0 + 1];
    float vn0[4], vn1[4];
#pragma unroll
    for (int t = 0; t < 4; ++t) { const size_t row = (size_t)TP + n * 4 + t; const unsigned raw = *(const unsigned*)(PROJ + row * NPROJ + C_VS + c0);
        const float x0 = bf2f(raw & 0xffffu), x1 = bf2f(raw >> 16);
        const float mu = wave_sum(x0 + x1) * (1.f / 128.f), d0 = x0 - mu, d1 = x1 - mu;
        const float rstd = rsqrtf(wave_sum(d0 * d0 + d1 * d1) * (1.f / 128.f) + EPS);
        vn0[t] = d0 * rstd * g0 + b0; vn1[t] = d1 * rstd * g1 + b1;
        *(f32x2*)(vout + ((size_t)n * 4 + t) * 512 + c0) = (f32x2){vn0[t], vn1[t]}; }
#pragma unroll
    for (int t = 0; t < 4; ++t) { const size_t row = (size_t)TP + n * 4 + t; float m0 = bsp[hh * 128 + t], m1 = m0;
#pragma unroll
        for (int s = 0; s < 4; ++s) if (s <= t) { const float wv = wsp[((size_t)hh * 128 + t) * 128 + s]; m0 += wv * vn0[s]; m1 += wv * vn1[s]; }
        const unsigned uw = *(const unsigned*)(PROJ + row * NPROJ + C_U + c0);
        *(unsigned*)(MIXIN + row * D + 512 + c0) = pk2(bf2f(uw & 0xffffu) * m0, bf2f(uw >> 16) * m1); }
}

__device__ __forceinline__ void act_item(int item, u16* UP, const u16* HALO, const float* sconv, const float* wconv, const float* bconv, float* out, int lane) {
    const int rb = item / 22, cch = item - rb * 22, j0 = cch * 128 + 2 * lane;
    float wgt[3][2], wvl[3][2], bg[2], bv[2];
#pragma unroll
    for (int k = 0; k < 3; ++k) { const f32x2 a = *(const f32x2*)(wconv + k * FF2 + j0), b = *(const f32x2*)(wconv + k * FF2 + FF + j0); wgt[k][0] = a.x; wgt[k][1] = a.y; wvl[k][0] = b.x; wvl[k][1] = b.y; }
    { const f32x2 a = *(const f32x2*)(bconv + j0), b = *(const f32x2*)(bconv + FF + j0); bg[0] = a.x; bg[1] = a.y; bv[0] = b.x; bv[1] = b.y; }
    const bool sample = rb >= 256;
    float g2[2] = {0.f, 0.f}, g1[2] = {0.f, 0.f}, v2[2] = {0.f, 0.f}, v1[2] = {0.f, 0.f};
    if (!sample && (rb & 31) != 0) {
        const unsigned a = *(const unsigned*)(HALO + (size_t)((rb - 1) * 2) * FF2 + j0), b = *(const unsigned*)(HALO + (size_t)((rb - 1) * 2) * FF2 + FF + j0);
        const unsigned c = *(const unsigned*)(HALO + (size_t)((rb - 1) * 2 + 1) * FF2 + j0), dd = *(const unsigned*)(HALO + (size_t)((rb - 1) * 2 + 1) * FF2 + FF + j0);
        g2[0] = bf2f(a & 0xffffu); g2[1] = bf2f(a >> 16); v2[0] = bf2f(b & 0xffffu); v2[1] = bf2f(b >> 16);
        g1[0] = bf2f(c & 0xffffu); g1[1] = bf2f(c >> 16); v1[0] = bf2f(dd & 0xffffu); v1[1] = bf2f(dd >> 16);
    }
    for (int tb = 0; tb < 64; tb += 16) {
        unsigned gw[16], vw[16];
#pragma unroll
        for (int t = 0; t < 16; ++t) { const size_t row = (size_t)rb * 64 + tb + t; gw[t] = *(const unsigned*)(UP + row * FF2 + j0); vw[t] = *(const unsigned*)(UP + row * FF2 + FF + j0); }
#pragma unroll
        for (int t = 0; t < 16; ++t) {
            const int row = rb * 64 + tb + t;
            if (sample && (t & 3) == 0) { const int ns = (row - TP) >> 2; const float* s0 = sconv + (size_t)ns * 2 * FF2;
                const f32x2 a = *(const f32x2*)(s0 + j0), b = *(const f32x2*)(s0 + FF + j0), c = *(const f32x2*)(s0 + FF2 + j0), dd = *(const f32x2*)(s0 + FF2 + FF + j0);
                g2[0] = a.x; g2[1] = a.y; v2[0] = b.x; v2[1] = b.y; g1[0] = c.x; g1[1] = c.y; v1[0] = dd.x; v1[1] = dd.y; }
            const float g0[2] = {bf2f(gw[t] & 0xffffu), bf2f(gw[t] >> 16)}, v0[2] = {bf2f(vw[t] & 0xffffu), bf2f(vw[t] >> 16)};
            float res[2];
#pragma unroll
            for (int p = 0; p < 2; ++p) { const float cgv = bg[p] + wgt[0][p] * g2[p] + wgt[1][p] * g1[p] + wgt[2][p] * g0[p];
                const float cvv = bv[p] + wvl[0][p] * v2[p] + wvl[1][p] * v1[p] + wvl[2][p] * v0[p]; res[p] = gelu_t(cgv) * cvv;
                g2[p] = g1[p]; g1[p] = g0[p]; v2[p] = v1[p]; v1[p] = v0[p]; }
            *(unsigned*)(UP + (size_t)row * FF2 + j0) = pk2(res[0], res[1]);
            if (!sample) { const int tq = row & 2047; if (tq >= 2046) { float* o = out + O_CONVP + ((size_t)(row >> 11) * 2 + (tq - 2046)) * FF2;
                    *(f32x2*)(o + j0) = (f32x2){g0[0], g0[1]}; *(f32x2*)(o + FF + j0) = (f32x2){v0[0], v0[1]}; } }
            else if ((t & 3) >= 2) { const int ns = (row - TP) >> 2; float* o = out + O_CONVS + ((size_t)ns * 2 + ((t & 3) - 2)) * FF2;
                    *(f32x2*)(o + j0) = (f32x2){g0[0], g0[1]}; *(f32x2*)(o + FF + j0) = (f32x2){v0[0], v0[1]}; }
        }
    }
}

__global__ void __launch_bounds__(512, 2) fwd_kernel(Args args) {
    extern __shared__ __attribute__((aligned(16))) unsigned char lds_raw[];
    LAS unsigned char* lds = (LAS unsigned char*)lds_raw;
    cg::grid_group grid = cg::this_grid();
    const int tid = threadIdx.x, lane = tid & 63, wave = __builtin_amdgcn_readfirstlane(tid >> 6);
    const int G = gridDim.x, bid = blockIdx.x, gw = bid * 8 + wave, NGW = G * 8;
    unsigned char* ws = args.ws; float* out = args.out;
    u16* WinT = (u16*)(ws + WS_WIN); u16* WoutT = (u16*)(ws + WS_WOUT); u16* WupT = (u16*)(ws + WS_WUP); u16* WdnT = (u16*)(ws + WS_WDN); u16* WpgT = (u16*)(ws + WS_WPG); u16* WpleT = (u16*)(ws + WS_WPLE);
    u16* H = (u16*)(ws + WS_H); u16* HALO = (u16*)(ws + WS_HALO); u16* X1B = (u16*)(out + O_Y);
    u16* PROJ = (u16*)(ws + WS_BIG); u16* UP = (u16*)(ws + WS_BIG); float* Z = (float*)(ws + WS_BIG);
    u16* MIXB = (u16*)(ws + WS_BIG2); u16* PB = (u16*)(ws + 9 * MiB);
    float* GLS = (float*)(ws + WS_WIN);
    float* FT3 = (float*)(ws + WS_BIG); float* FT7 = (float*)(ws + WS_WIN);
    const float* xp = args.in[I_XP]; const float* xs = args.in[I_XS];
    const int lo = args.ph_lo, hi = args.ph_hi;
#define IN(k) (lo <= (k) && (k) < hi)
    volatile LAS unsigned* MISC = (volatile LAS unsigned*)(lds + MISC_OFF);
    if (tid < 4) MISC[tid] = 0u;
    __syncthreads();
    XcdBarrier xbar = xcd_barrier_post((unsigned*)(ws + WS_CTL), MISC);
    if (lo < 0) grid.sync();
#define SYNC(k) do { if (IN(k) && IN((k) + 1)) xcd_barrier(xbar); } while (0)
#define IDLE_RANK(nun, rank, nidle) const int _f##rank = (nun) % G; const int rank = _f##rank ? bid - _f##rank : bid; const int nidle = _f##rank ? G - _f##rank : G;
#define XROW(m) ((m) < TP ? xp + (size_t)(m) * D : xs + (size_t)((m) - TP) * D)

    if (IN(0)) {
        LAS float* scr = (LAS float*)lds;
        constexpr int T_IN = 16 * 44, T_OUT = 16 * 16, T_UP = 16 * 88, T_DN = 44 * 16, T_PG = 16 * 16, T_PLE = 4 * 16, NT = T_IN + T_OUT + T_UP + T_DN + T_PG + T_PLE;
        (void)NT;
        for (int r = bid; r < T_IN; r += G) transpose_tile(args.in[I_WIN], D, NIN, WinT, (r / 44) * 64, (r % 44) * 64, scr, tid);
        for (int m0 = gw; m0 < T; m0 += NR * NGW) { RowPtrs r[NR];
#pragma unroll
            for (int k = 0; k < NR; ++k) { const int m = (m0 + k * NGW < T) ? m0 + k * NGW : m0; r[k] = RowPtrs{nullptr, nullptr, XROW(m), nullptr, H + (size_t)m * D, false}; }
            row_op2<0, 0>(r, false, nullptr, args.in[I_GMIXPRE], lane); }
    }
    SYNC(0);
    if (IN(1)) {
        pg8::Gemm g{H, WinT, T, NPROJ, D, D}; pg8::StaticOrder S; S.init(T, NPROJ, D, G, bid, 0, 1);
        pg8::EpiBf16 E{PROJ, NPROJ, nullptr, nullptr, 0, 0, D, C_U, C_R, C_GLR};
        pg8::gemm_phase<pg8::EpiBf16>(lds, g, S, E);
        { IDLE_RANK(66 * 11, rk, ni); LAS float* scr = (LAS float*)lds;
          if (rk >= 0) for (int r = rk; r < 16 * 16; r += ni) transpose_tile(args.in[I_WOUT], D, D, WoutT, (r / 16) * 64, (r % 16) * 64, scr, tid); }
    }
    SYNC(1);
    if (IN(2)) {
        u16* MIXIN = H; float* GS = (float*)(ws + WS_BIG2); float* GDEC = (float*)(ws + WS_BIG2 + 40 * MiB); u16* GSB = (u16*)(ws + WS_BIG2 + 48 * MiB);
        int hh_cached = -1;
        GateW gwt; gwt.h = -1; gwt.bgd = 0.f;
#pragma unroll
        for (int r = 0; r < 16; ++r) gwt.wg[r] = 0.f;
        for (int it = bid; it < 2048; it += G) {
            if (it < 512) sgu_prompt_item(it, PROJ, MIXIN, args.in[I_GSGULN], args.in[I_BSGULN], args.in[I_WSPAT], args.in[I_BSPAT], lds, hh_cached);
            else if (it < 1536) gla_chunk_item<0>(it - 512, PROJ, MIXIN, args.in[I_WGATE], args.in[I_BGATE], args.in[I_GGLAOUT], GS, GDEC, GSB, lds, gwt);
            else gla_sample_item(it - 1536, PROJ, MIXIN, args.in[I_WGATE], args.in[I_BGATE], args.in[I_GGLAOUT], args.in[I_SGLA], out + O_GLAS, lds);
        }
        for (int it = gw; it < 512; it += NGW) sgu_sample_item(it, PROJ, MIXIN, args.in[I_GSGULN], args.in[I_BSGULN], args.in[I_WSPAT], args.in[I_BSPAT], out + O_SGUV, lane);
        xcd_barrier(xbar);
        for (int gid = bid * 512 + tid; gid < 32 * 4096; gid += G * 512) gla_scan(gid, GS, GSB, GDEC, out + O_GLAP);
        xcd_barrier(xbar);
        for (int it = bid; it < 1024; it += G) gla_chunk_item<1>(it, PROJ, MIXIN, args.in[I_WGATE], args.in[I_BGATE], args.in[I_GGLAOUT], GS, GDEC, GSB, lds, gwt);
    }
    SYNC(2);
    if (IN(3)) {
        pg8::Gemm g{H, WoutT, T, D, D, D}; pg8::StaticOrder S; S.init(T, D, D, G, bid, 2, 4);
        pg8::EpiBf16 E{MIXB, D, nullptr, FT3, TP, (size_t)TS * D, D, 0x7fffffff, 0, 0};
        pg8::gemm_phase<pg8::EpiBf16>(lds, g, S, E);
        { const int f = (G > 32) ? 32 : 0, rk = bid - f, ni = G - f; LAS float* scr = (LAS float*)lds;
          if (rk >= 0) for (int r = rk; r < 16 * 88; r += ni) transpose_tile(args.in[I_WUP], D, FF2, WupT, (r / 88) * 64, (r % 88) * 64, scr, tid); }
    }
    SYNC(3);
    if (IN(4)) {
        for (int m0 = gw; m0 < T; m0 += NR * NGW) { RowPtrs r[NR];
#pragma unroll
            for (int k = 0; k < NR; ++k) { const int m = (m0 + k * NGW < T) ? m0 + k * NGW : m0;
                r[k] = RowPtrs{m < TP ? nullptr : FT3 + (size_t)(m - TP) * D, MIXB + (size_t)m * D, XROW(m), X1B + (size_t)m * D, H + (size_t)m * D, m >= TP}; }
            row_op2<0, 1>(r, true, args.in[I_GMIXPOST], args.in[I_GFFNPRE], lane); }
    }
    SYNC(4);
    if (IN(5)) {
        pg8::Gemm g{H, WupT, T, FF2, D, D}; pg8::StaticOrder S; S.init(T, FF2, D, G, bid, 0, 1);
        pg8::EpiBf16 E{UP, FF2, HALO, nullptr, 0, 0, D, 0x7fffffff, 0, 0};
        pg8::gemm_phase<pg8::EpiBf16>(lds, g, S, E);
        { IDLE_RANK(66 * 22, rk, ni); LAS float* scr = (LAS float*)lds;
          if (rk >= 0) for (int it = rk; it < 44 * 16 + 16 * 16 + 4 * 16; it += ni) { int r = it;
              if (r < 44 * 16) { transpose_tile(args.in[I_WDOWN], FF, D, WdnT, (r / 16) * 64, (r % 16) * 64, scr, tid); continue; } r -= 44 * 16;
              if (r < 16 * 16) { transpose_tile(args.in[I_WPG], D, D, WpgT, (r / 16) * 64, (r % 16) * 64, scr, tid); continue; } r -= 16 * 16;
              transpose_tile(args.in[I_WPLE], PLE, D, WpleT, (r / 16) * 64, (r % 16) * 64, scr, tid); } }
    }
    SYNC(5);
    if (IN(6)) {
        for (int it = gw; it < 264 * 22; it += NGW) act_item(it, UP, HALO, args.in[I_SCONV], args.in[I_WCONV], args.in[I_BCONV], out, lane);
        for (int m = gw; m < T; m += NGW) {
            const float* pp = (m < TP) ? args.in[I_PP] + (size_t)m * PLE : args.in[I_PS] + (size_t)(m - TP) * PLE;
            const f32x4 v = ((const f32x4*)pp)[lane]; u32x2 wv; wv.x = pk2(v.x, v.y); wv.y = pk2(v.z, v.w); ((u32x2*)(PB + (size_t)m * PLE))[lane] = wv; }
    }
    SYNC(6);
    if (IN(7)) {
        pg8::Gemm g{UP, WdnT, T, D, FF, FF2}; pg8::StaticOrder S; S.init(T, D, FF, G, bid, 2, 4);
        pg8::EpiBf16 E{H, D, nullptr, FT7, TP, (size_t)TS * D, D, 0x7fffffff, 0, 0};
        pg8::gemm_phase<pg8::EpiBf16>(lds, g, S, E);
        if (bid >= 32 && G > 32) {
            pg8::Gemm g2{PB, WpleT, T, D, PLE, PLE}; pg8::StaticOrder S2; S2.init(T, D, PLE, G - 32, bid - 32, 0, 1);
            pg8::EpiBf16 E2{UP + FF, FF2, nullptr, nullptr, 0, 0, D, 0x7fffffff, 0, 0};
            pg8::gemm_phase<pg8::EpiBf16>(lds, g2, S2, E2);
        }
    }
    SYNC(7);
    if (IN(8)) {
        for (int m0 = gw; m0 < T; m0 += NR * NGW) { RowPtrs r[NR];
#pragma unroll
            for (int k = 0; k < NR; ++k) { const int m = (m0 + k * NGW < T) ? m0 + k * NGW : m0;
                r[k] = RowPtrs{m < TP ? nullptr : FT7 + (size_t)(m - TP) * D, H + (size_t)m * D, X1B + (size_t)m * D, UP + (size_t)m * FF2, H + (size_t)m * D, m >= TP}; }
            row_op2<1, 1>(r, true, args.in[I_GFFNPOST], args.in[I_GPLEIN], lane); }
    }
    SYNC(8);
    if (IN(9)) {
        pg8::Gemm g{H, WpgT, T, D, D, D}; pg8::StaticOrder S; S.init(T, D, D, G, bid, 2, 4);
        pg8::EpiBf16 E{UP + FF + D, FF2, nullptr, GLS, TP, (size_t)TS * D, D, 0x7fffffff, 0, 0};
        pg8::gemm_phase<pg8::EpiBf16>(lds, g, S, E);
    }
    SYNC(9);
    if (IN(10)) {
        for (int m0 = gw; m0 < T; m0 += NR * NGW) { FinPtrs r[NR];
#pragma unroll
            for (int k = 0; k < NR; ++k) { const int m = (m0 + k * NGW < T) ? m0 + k * NGW : m0;
                r[k] = FinPtrs{UP + (size_t)m * FF2 + FF, UP + (size_t)m * FF2 + FF + D, nullptr, m < TP ? nullptr : GLS + (size_t)(m - TP) * D, UP + (size_t)m * FF2, out + O_Y + (size_t)m * D}; }
            row_final2(r, args.in[I_GPLEPOST], lane); }
    }
#undef IN
#undef SYNC
#undef XROW
}

#ifndef N_LAUNCH
#define N_LAUNCH 1
#endif
extern "C" void kernel_launch(void* const* d_in, const int* in_sizes, int n_in, void* d_out, int out_size, void* d_ws, size_t ws_size, hipStream_t stream) {
    static int grid = 0;
    if (grid == 0) {
        int dev = 0, cus = 0, per_cu = 0;
        hipGetDevice(&dev);
        hipDeviceGetAttribute(&cus, hipDeviceAttributeMultiprocessorCount, dev);
        hipFuncSetAttribute((const void*)fwd_kernel, hipFuncAttributeMaxDynamicSharedMemorySize, LDS_BYTES);
        hipOccupancyMaxActiveBlocksPerMultiprocessor(&per_cu, (const void*)fwd_kernel, 512, LDS_BYTES);
        (void)hipGetLastError();
        grid = cus > 0 ? cus : 256;
        if (n_in != 27 || ws_size < WS_END) { fprintf(stderr, "kernel_launch: unexpected n_in %d / ws %zu\n", n_in, ws_size); }
        if (per_cu < 1) fprintf(stderr, "kernel_launch: occupancy query says %d blocks per CU\n", per_cu);
    }
    if (hipMemsetAsync((char*)d_ws + WS_CTL, 0, CTL_BYTES, stream) != hipSuccess) fprintf(stderr, "kernel_launch: memset of barrier words failed\n");
    Args a{};
    for (int i = 0; i < 27; ++i) a.in[i] = (const float*)d_in[i];
    a.out = (float*)d_out; a.ws = (unsigned char*)d_ws;
    if (N_LAUNCH == 1) {
        a.ph_lo = 0; a.ph_hi = 11;
        void* kargs[] = {&a};
        hipError_t e = hipLaunchCooperativeKernel((const void*)fwd_kernel, dim3(grid), dim3(512), kargs, LDS_BYTES, stream);
        if (e != hipSuccess) fprintf(stderr, "cooperative launch failed: %s (grid %d)\n", hipGetErrorString(e), grid);
    } else {
        for (int p = 0; p < 11; ++p) { a.ph_lo = p; a.ph_hi = p + 1; hipLaunchKernelGGL(fwd_kernel, dim3(grid), dim3(512), LDS_BYTES, stream, a); }
    }
}
```

```cpp
#include <hip/hip_runtime.h>
#include <hip/hip_cooperative_groups.h>
#include <cstdio>
namespace cg = cooperative_groups;

#define LAS __attribute__((address_space(3)))
typedef unsigned short u16;
typedef short bf16x8 __attribute__((ext_vector_type(8)));
typedef float f32x4 __attribute__((ext_vector_type(4)));
typedef float f32x2 __attribute__((ext_vector_type(2)));
typedef unsigned u32x4 __attribute__((ext_vector_type(4)));
typedef unsigned u32x2 __attribute__((ext_vector_type(2)));

constexpr int TP = 16384, TS = 512, T = TP + TS, D = 1024, NPROJ = 2816, NIN = 2576, FF = 2816, FF2 = 5632, PLE = 256;
constexpr int C_Q = 0, C_K = 256, C_V = 512, C_R = 1024, C_GLR = 1536, C_U = 1552, C_VS = 2064;
constexpr float EPS = 1e-6f;
constexpr size_t O_Y = 0, O_GLAP = 17301504, O_GLAS = 17563648, O_CONVP = 21757952, O_CONVS = 21848064, O_SGUV = 23289856;
constexpr size_t MiB = 1u << 20;
constexpr size_t WS_WIN = 0, WS_WOUT = WS_WIN + (size_t)NPROJ * D * 2, WS_WUP = WS_WOUT + (size_t)D * D * 2, WS_WDN = WS_WUP + (size_t)FF2 * D * 2,
                 WS_WPG = WS_WDN + (size_t)D * FF * 2, WS_WPLE = WS_WPG + (size_t)D * D * 2, WS_WEND = WS_WPLE + (size_t)D * PLE * 2;
constexpr size_t WS_H = 28 * MiB, WS_HALO = 61 * MiB, WS_BIG = 67 * MiB, WS_BIG2 = WS_BIG + 96 * MiB, WS_END = WS_BIG + (size_t)T * FF2 * 2;
static_assert(WS_WEND <= WS_H && WS_H + (size_t)T * D * 2 <= WS_HALO && WS_HALO + (size_t)264 * 2 * FF2 * 2 <= WS_BIG && WS_END <= 256 * MiB, "ws map");
static_assert(WS_BIG + (size_t)T * NPROJ * 2 <= WS_BIG2 && WS_BIG2 + (size_t)T * D * 4 <= WS_END, "ws map 2");
constexpr size_t WS_CTL = 255 * MiB, CTL_BYTES = 16384;
constexpr int LDS_BYTES = 135168, MISC_OFF = 131072;

__device__ __forceinline__ float bf2f(unsigned b) { return __uint_as_float(b << 16); }
__device__ __forceinline__ unsigned pk2(float lo, float hi) { unsigned r; asm("v_cvt_pk_bf16_f32 %0, %1, %2" : "=v"(r) : "v"(lo), "v"(hi)); return r; }
__device__ __forceinline__ float wave_sum(float v) {
#pragma unroll
    for (int o = 1; o < 64; o <<= 1) v += __shfl_xor(v, o);
    return v;
}
__device__ __forceinline__ float sigmoidf_(float x) { return __builtin_amdgcn_rcpf(1.f + __expf(-x)); }
__device__ __forceinline__ float gelu_t(float x) { return x * __builtin_amdgcn_rcpf(1.f + __expf(-1.5957691216057308f * (x + 0.044715f * x * x * x))); }
__device__ __forceinline__ float logsig(float x) { return fminf(x, 0.f) - __logf(1.f + __expf(-fabsf(x))); }
__device__ __forceinline__ float rdlane(float v, int l) { return __uint_as_float(__builtin_amdgcn_readlane(__float_as_uint(v), l)); }

namespace pg8 {
constexpr int BM = 256, BK = 64, HALF = 128, HTB = HALF * BK * 2, STAGE_BYTES = 8 * HTB, NXCD = 8, WGM = 4;
__device__ __forceinline__ int lds_byte(int r, int c) { const int st = (r >> 4) * 2 + (c >> 5), rr = r & 15, cc = c & 31, ob = rr * 64 + cc * 2; return st * 1024 + (ob ^ (((ob >> 9) & 1) << 5)); }
__device__ __forceinline__ void stage_rc(int b, int& R, int& C) { const int st = b / 1024, sb = b % 1024, swz = sb ^ (((sb >> 9) & 1) << 5); R = (st >> 1) * 16 + swz / 64; C = (st & 1) * 32 + (swz % 64) / 2; }
__device__ __forceinline__ int perm32(int rho) { const int n = rho >> 4, i = rho & 15; return 8 * (i >> 2) + 4 * n + (i & 3); }
struct Unit { int pm, pn, kt0, nkt, part; };
struct Gemm { const u16* A; const u16* Bt; int M, N, K, lda; };
struct StaticOrder {
    int nM, nN, nwg, G, c, nt, tail, split;
    __device__ void init(int M, int N, int K, int G_, int c_, int tail_, int split_) { tail = tail_; split = split_; nM = M / BM - tail; nN = N / BM; nwg = nM * nN; G = G_; c = c_; nt = K / BK; }
    __device__ bool next(int i, Unit& u) const {
        long L = (long)i * G + c;
        if (L < nwg) {
            int wgid = (int)L; { const int q = nwg / NXCD, r = nwg % NXCD, xcd = wgid % NXCD, off = wgid / NXCD; wgid = (xcd < r ? xcd * (q + 1) : r * (q + 1) + (xcd - r) * q) + off; }
            const int nig = WGM * nN, gid = wgid / nig, fm = gid * WGM, gsz = (nM - fm) < WGM ? (nM - fm) : WGM;
            u.pm = fm + ((wgid % nig) % gsz); u.pn = (wgid % nig) / gsz; u.kt0 = 0; u.nkt = nt; u.part = 0; return true;
        }
        L -= nwg; if (L >= (long)tail * nN * split) return false;
        const int ks = (int)L % split, tu = (int)L / split, pairs = nt / 2, base = pairs / split, ex = pairs % split;
        u.pm = nM + tu / nN; u.pn = tu % nN; u.kt0 = 2 * (ks * base + (ks < ex ? ks : ex)); u.nkt = 2 * (base + (ks < ex ? 1 : 0)); u.part = ks + 1; return true;
    }
};
struct EpiF32 {
    static constexpr bool PERM = false;
    float* C; int ldc; float* parts; int tail_row0; size_t slab;
    __device__ __forceinline__ void operator()(const f32x4 (&acc)[2][2][4][2], const Unit& u, int wr, int wc, int fr, int fq) const {
        const int row0 = u.pm * BM + wr * 64 + fr, col0 = u.pn * BM + wc * 32 + 4 * fq;
        float* base = u.part ? parts + (size_t)(u.part - 1) * slab - (size_t)tail_row0 * ldc : C;
#pragma unroll
        for (int ai = 0; ai < 2; ++ai)
#pragma unroll
            for (int m = 0; m < 4; ++m) { float* rowp = base + (size_t)(row0 + ai * HALF + m * 16) * ldc + col0;
#pragma unroll
                for (int bj = 0; bj < 2; ++bj)
#pragma unroll
                    for (int n = 0; n < 2; ++n) *(f32x4*)(rowp + bj * HALF + n * 16) = acc[ai][bj][m][n]; }
    }
};
struct EpiGateMul {
    static constexpr bool PERM = false;
    float* C; int ldc;
    __device__ __forceinline__ void operator()(const f32x4 (&acc)[2][2][4][2], const Unit& u, int wr, int wc, int fr, int fq) const {
        const int row0 = u.pm * BM + wr * 64 + fr, col0 = u.pn * BM + wc * 32 + 4 * fq;
#pragma unroll
        for (int ai = 0; ai < 2; ++ai)
#pragma unroll
            for (int m = 0; m < 4; ++m) { float* rowp = C + (size_t)(row0 + ai * HALF + m * 16) * ldc + col0;
#pragma unroll
                for (int bj = 0; bj < 2; ++bj)
#pragma unroll
                    for (int n = 0; n < 2; ++n) { f32x4 c = *(f32x4*)(rowp + bj * HALF + n * 16); const f32x4 a = acc[ai][bj][m][n];
                        c.x *= sigmoidf_(a.x); c.y *= sigmoidf_(a.y); c.z *= sigmoidf_(a.z); c.w *= sigmoidf_(a.w);
                        *(f32x4*)(rowp + bj * HALF + n * 16) = c; } }
    }
};
struct EpiBf16 {
    static constexpr bool PERM = true;
    u16* O; int ldc; u16* halo; float* tailacc; int tail_row0; size_t slab; int tail_ld; int gelu_from;
    __device__ __forceinline__ void operator()(const f32x4 (&acc)[2][2][4][2], const Unit& u, int wr, int wc, int fr, int fq) const {
        const int row0 = u.pm * BM + wr * 64 + fr, col0 = u.pn * BM + wc * 32 + 8 * fq;
        if (u.part) {
            float* base = tailacc + (size_t)(u.part - 1) * slab - (size_t)tail_row0 * tail_ld;
#pragma unroll
            for (int ai = 0; ai < 2; ++ai)
#pragma unroll
                for (int m = 0; m < 4; ++m) { float* rowp = base + (size_t)(row0 + ai * HALF + m * 16) * tail_ld + col0;
#pragma unroll
                    for (int bj = 0; bj < 2; ++bj)
#pragma unroll
                        for (int n = 0; n < 2; ++n) *(f32x4*)(rowp + bj * HALF + 4 * n) = acc[ai][bj][m][n]; }
            return;
        }
#pragma unroll
        for (int ai = 0; ai < 2; ++ai)
#pragma unroll
            for (int m = 0; m < 4; ++m) { const int row = row0 + ai * HALF + m * 16; u16* rowp = O + (size_t)row * ldc + col0;
#pragma unroll
                for (int bj = 0; bj < 2; ++bj) { f32x4 v0 = acc[ai][bj][m][0], v1 = acc[ai][bj][m][1];
                    if (col0 + bj * HALF >= gelu_from) { v0 = (f32x4){gelu_t(v0.x), gelu_t(v0.y), gelu_t(v0.z), gelu_t(v0.w)}; v1 = (f32x4){gelu_t(v1.x), gelu_t(v1.y), gelu_t(v1.z), gelu_t(v1.w)}; }
                    u32x4 w; w.x = pk2(v0[0], v0[1]); w.y = pk2(v0[2], v0[3]); w.z = pk2(v1[0], v1[1]); w.w = pk2(v1[2], v1[3]);
                    *(u32x4*)(rowp + bj * HALF) = w;
                    if (halo != nullptr && m == 3 && fr >= 14) *(u32x4*)(halo + (size_t)((row >> 6) * 2 + (fr - 14)) * ldc + col0 + bj * HALF) = w; } }
    }
};

template <class Epi>
__device__ __forceinline__ void gemm_phase(LAS unsigned char* lds, const Gemm g, const StaticOrder& S, const Epi& E) {
    const int tid = threadIdx.x, wid = __builtin_amdgcn_readfirstlane(tid >> 6), lane = tid & 63, wr = wid >> 2, wc = wid & 3, fr = lane & 15, fq = lane >> 4;
    const int K = g.K, lda = g.lda;
    unsigned voffA[2], voffB[2];
#pragma unroll
    for (int i = 0; i < 2; ++i) { int R, C; stage_rc(tid * 16 + i * 8192, R, C); const int Rb = Epi::PERM ? ((R & ~31) + perm32(R & 31)) : R;
        voffA[i] = (unsigned)(R * lda + C) * 2u; voffB[i] = (unsigned)(Rb * K + C) * 2u; }
    const size_t kstep = (size_t)(BK * 2);
    const size_t hstepA = (size_t)HALF * lda * 2, hstepB = (size_t)HALF * K * 2;
    const size_t tstepA = 2 * hstepA, tstepB = 2 * hstepB;
    const unsigned ldsw = (unsigned)wid * 1024u;
    const int aoff = lds_byte(wr * 64 + fr, fq * 8), boff = lds_byte(wc * 32 + fr, fq * 8);
#define PG8_SA(b, h) (((b) * 2 + (h)) * HTB)
#define PG8_SB(b, h) ((4 + (b) * 2 + (h)) * HTB)
#define PG8_STAGE(bufoff, gbase, voff) do { _Pragma("unroll") for (int _i = 0; _i < 2; ++_i) \
        __builtin_amdgcn_global_load_lds((const unsigned*)((const char*)(gbase) + (voff)[_i]), (LAS unsigned*)(lds + (bufoff) + ldsw + _i * 8192), 16, 0, 0); } while (0)
#define PG8_LDA(dst, b, h) do { _Pragma("unroll") for (int m = 0; m < 4; ++m) _Pragma("unroll") for (int k = 0; k < 2; ++k) dst[m][k] = *(const LAS bf16x8*)(lds + PG8_SA(b, h) + aoff + m * 2048 + k * 1024); } while (0)
#define PG8_LDB(dst, b, h) do { _Pragma("unroll") for (int n = 0; n < 2; ++n) _Pragma("unroll") for (int k = 0; k < 2; ++k) dst[n][k] = *(const LAS bf16x8*)(lds + PG8_SB(b, h) + boff + n * 2048 + k * 1024); } while (0)
#define PG8_MMA(ai, bj, At, Bt) do { __builtin_amdgcn_s_setprio(1); _Pragma("unroll") for (int m = 0; m < 4; ++m) _Pragma("unroll") for (int n = 0; n < 2; ++n) _Pragma("unroll") for (int k = 0; k < 2; ++k) \
        acc[ai][bj][m][n] = __builtin_amdgcn_mfma_f32_16x16x32_bf16(Bt[n][k], At[m][k], acc[ai][bj][m][n], 0, 0, 0); __builtin_amdgcn_s_setprio(0); } while (0)
#define PG8_WAIT_V(n) asm volatile("s_waitcnt vmcnt(" #n ")" ::: "memory")
#define PG8_WAIT_L(n) asm volatile("s_waitcnt lgkmcnt(" #n ")" ::: "memory")
#define PG8_BAR __builtin_amdgcn_s_barrier()
#define PG8_SCHED __builtin_amdgcn_sched_barrier(0)
    Unit cur, nxt; int ui = 0;
    if (!S.next(0, cur)) return;
    f32x4 acc[2][2][4][2];
#pragma unroll
    for (int a = 0; a < 2; ++a)
#pragma unroll
        for (int b = 0; b < 2; ++b)
#pragma unroll
            for (int m = 0; m < 4; ++m)
#pragma unroll
                for (int n = 0; n < 2; ++n) acc[a][b][m][n] = (f32x4){0.f, 0.f, 0.f, 0.f};
    bf16x8 At[4][2], B0[2][2], B1[2][2];
    const char* cA = (const char*)g.A + (size_t)cur.pm * tstepA + (size_t)cur.kt0 * kstep; const char* cB = (const char*)g.Bt + (size_t)cur.pn * tstepB + (size_t)cur.kt0 * kstep;
    PG8_STAGE(PG8_SB(0, 0), cB, voffB); PG8_STAGE(PG8_SA(0, 0), cA, voffA); PG8_STAGE(PG8_SB(0, 1), cB + hstepB, voffB); PG8_STAGE(PG8_SA(0, 1), cA + hstepA, voffA);
    if (wr == 1) PG8_BAR;
    PG8_WAIT_V(4); PG8_BAR;
    PG8_STAGE(PG8_SB(1, 0), cB + kstep, voffB); PG8_STAGE(PG8_SA(1, 0), cA + kstep, voffA); PG8_STAGE(PG8_SB(1, 1), cB + hstepB + kstep, voffB);
    PG8_WAIT_V(6); PG8_BAR;
    for (;;) {
        const bool has_next = S.next(ui + 1, nxt);
        const char* nA = has_next ? (const char*)g.A + (size_t)nxt.pm * tstepA + (size_t)nxt.kt0 * kstep : cA; const char* nB = has_next ? (const char*)g.Bt + (size_t)nxt.pn * tstepB + (size_t)nxt.kt0 * kstep : cB;
        const int nt = cur.nkt;
        for (int t = 0; t < nt; t += 2) {
            const bool last = (t == nt - 2);
            const char* a1 = cA + (size_t)(t + 1) * kstep;
            const char* a2 = last ? nA : cA + (size_t)(t + 2) * kstep; const char* b2 = last ? nB : cB + (size_t)(t + 2) * kstep;
            const char* a3 = a2 + kstep; const char* b3 = b2 + kstep;
            PG8_LDB(B0, 0, 0); PG8_SCHED; PG8_LDA(At, 0, 0); PG8_STAGE(PG8_SA(1, 1), a1 + hstepA, voffA);
            PG8_WAIT_L(8); PG8_BAR; PG8_WAIT_L(0); PG8_MMA(0, 0, At, B0); PG8_BAR; PG8_SCHED;
            PG8_LDB(B1, 0, 1); PG8_STAGE(PG8_SB(0, 0), b2, voffB);
            PG8_BAR; PG8_WAIT_L(0); PG8_MMA(0, 1, At, B1); PG8_BAR;
            PG8_LDA(At, 0, 1); PG8_STAGE(PG8_SA(0, 0), a2, voffA);
            PG8_BAR; PG8_WAIT_L(0); PG8_MMA(1, 0, At, B0); PG8_BAR; PG8_SCHED;
            PG8_STAGE(PG8_SB(0, 1), b2 + hstepB, voffB);
            PG8_WAIT_V(6); PG8_BAR; PG8_MMA(1, 1, At, B1); PG8_BAR;
            PG8_LDB(B0, 1, 0); PG8_SCHED; PG8_LDA(At, 1, 0); PG8_STAGE(PG8_SA(0, 1), a2 + hstepA, voffA);
            PG8_WAIT_L(8); PG8_BAR; PG8_WAIT_L(0); PG8_MMA(0, 0, At, B0); PG8_BAR; PG8_SCHED;
            PG8_LDB(B1, 1, 1); PG8_STAGE(PG8_SB(1, 0), b3, voffB);
            PG8_BAR; PG8_WAIT_L(0); PG8_MMA(0, 1, At, B1); PG8_BAR;
            PG8_LDA(At, 1, 1); PG8_STAGE(PG8_SA(1, 0), a3, voffA);
            PG8_BAR; PG8_WAIT_L(0); PG8_MMA(1, 0, At, B0); PG8_BAR; PG8_SCHED;
            PG8_STAGE(PG8_SB(1, 1), b3 + hstepB, voffB);
            PG8_WAIT_V(6); PG8_BAR; PG8_MMA(1, 1, At, B1); PG8_BAR;
        }
        E(acc, cur, wr, wc, fr, fq);
        if (!has_next) break;
#pragma unroll
        for (int a = 0; a < 2; ++a)
#pragma unroll
            for (int b = 0; b < 2; ++b)
#pragma unroll
                for (int m = 0; m < 4; ++m)
#pragma unroll
                    for (int n = 0; n < 2; ++n) acc[a][b][m][n] = (f32x4){0.f, 0.f, 0.f, 0.f};
        cur = nxt; cA = nA; cB = nB; ++ui;
    }
    PG8_WAIT_V(0);
    if (wr == 0) PG8_BAR;
    PG8_BAR;
#undef PG8_SA
#undef PG8_SB
#undef PG8_STAGE
#undef PG8_LDA
#undef PG8_LDB
#undef PG8_MMA
#undef PG8_WAIT_V
#undef PG8_WAIT_L
#undef PG8_BAR
#undef PG8_SCHED
}
}


#define XB_TMO      128
#define XB_XCNT(j)  (256  + 64 * (j))
#define XB_XSUB(j)  (1280 + 64 * (j))
#define XB_XGEN(j)  (2304 + 64 * (j))
#define XB_TOP      3328
#define XB_TOPGEN   3392
#define XCD_BAR_WORDS 3456
#define XB_SPIN_CAP (1u << 22)
__device__ __forceinline__ unsigned xb_ld(unsigned* p)              { return __hip_atomic_load(p, __ATOMIC_RELAXED, __HIP_MEMORY_SCOPE_AGENT); }
__device__ __forceinline__ unsigned xb_add(unsigned* p, unsigned v) { return __hip_atomic_fetch_add(p, v, __ATOMIC_RELAXED, __HIP_MEMORY_SCOPE_AGENT); }
__device__ __forceinline__ unsigned xb_xcc_id() { return (unsigned)__builtin_amdgcn_s_getreg((3 << 11) | 20) & 0xFu; }
#define XB_SPIN(cond, bar) do { unsigned _sp = 0; while (cond) { __builtin_amdgcn_s_sleep(1); \
    if ((++_sp & 255u) == 0u) { if (xb_ld(&(bar)[XB_TMO])) break; if (_sp > XB_SPIN_CAP) { atomicAdd(&(bar)[XB_TMO], 1u); break; } } } } while (0)
struct XcdBarrier { unsigned* bar; unsigned x; volatile LAS unsigned* st; };
__device__ __forceinline__ XcdBarrier xcd_barrier_post(unsigned* bar, volatile LAS unsigned* st) {
    XcdBarrier b; b.bar = bar; b.x = xb_xcc_id(); b.st = st;
    if (threadIdx.x == 0) (void)xb_add(&bar[XB_XCNT(b.x)], 1u);
    return b;
}
__device__ __forceinline__ void xcd_barrier_complete(unsigned* bar, unsigned x, unsigned& nloc, unsigned& nx) {
    const unsigned G = gridDim.x * gridDim.y * gridDim.z;
    unsigned sum, cnt, mine, sp = 0u;
    for (;;) {
        sum = 0u; cnt = 0u; mine = 0u;
#pragma unroll
        for (unsigned j = 0; j < 16; ++j) { const unsigned c = xb_ld(&bar[XB_XCNT(j)]); sum += c; cnt += (c > 0u) ? 1u : 0u; mine = (j == x) ? c : mine; }
        if (sum == G) break;
        __builtin_amdgcn_s_sleep(1);
        if ((++sp & 255u) == 0u) { if (xb_ld(&bar[XB_TMO])) break; if (sp > XB_SPIN_CAP) { atomicAdd(&bar[XB_TMO], 1u); break; } }
    }
    nloc = mine > 0u ? mine : 1u; nx = cnt > 0u ? cnt : 1u;
}
__device__ __forceinline__ void xcd_barrier(const XcdBarrier& b) {
    asm volatile("s_waitcnt vmcnt(0)" ::: "memory");
    __syncthreads();
    if (threadIdx.x == 0) {
        unsigned* bar = b.bar;
        __builtin_amdgcn_s_waitcnt(0);
        unsigned nloc = b.st[0], nx = b.st[1];
        if (nloc == 0u) { xcd_barrier_complete(bar, b.x, nloc, nx); b.st[0] = nloc; b.st[1] = nx; }
        const unsigned old = xb_add(&bar[XB_XSUB(b.x)], 1u);
        const unsigned gen = old / nloc;
        if (old + 1u == (gen + 1u) * nloc) {
            __builtin_amdgcn_fence(__ATOMIC_RELEASE, "agent");
            asm volatile("s_waitcnt vmcnt(0)" ::: "memory");
            const unsigned og = xb_add(&bar[XB_TOP], 1u);
            const unsigned tg = og / nx;
            if (og + 1u == (tg + 1u) * nx) xb_add(&bar[XB_TOPGEN], 1u);
            else XB_SPIN(xb_ld(&bar[XB_TOPGEN]) == tg, bar);
            __builtin_amdgcn_fence(__ATOMIC_ACQUIRE, "agent");
            xb_add(&bar[XB_XGEN(b.x)], 1u);
            asm volatile("s_waitcnt vmcnt(0)" ::: "memory");
        } else {
            XB_SPIN(xb_ld(&bar[XB_XGEN(b.x)]) == gen, bar);
            __builtin_amdgcn_fence(__ATOMIC_ACQUIRE, "agent");
            asm volatile("s_waitcnt vmcnt(0)" ::: "memory");
        }
    }
    __syncthreads();
}

struct Args {
    const float* in[27];
    float* out; unsigned char* ws;
    int ph_lo, ph_hi;
};
enum { I_XP = 0, I_XS, I_SGLA, I_SCONV, I_PP, I_PS, I_GMIXPRE, I_WIN, I_WGATE, I_BGATE, I_GGLAOUT, I_GSGULN, I_BSGULN, I_WSPAT, I_BSPAT, I_WOUT, I_GMIXPOST,
       I_GFFNPRE, I_WUP, I_WCONV, I_BCONV, I_WDOWN, I_GFFNPOST, I_GPLEIN, I_WPG, I_WPLE, I_GPLEPOST };

__device__ __forceinline__ void transpose_tile(const float* W, int K, int N, u16* WT, int k0, int n0, LAS float* scr, int tid) {
#pragma unroll
    for (int i = 0; i < 8; ++i) { const int k = i * 8 + (tid >> 6), n = tid & 63; scr[k * 65 + n] = (n0 + n < N) ? W[(size_t)(k0 + k) * N + n0 + n] : 0.f; }
    __syncthreads();
    const int n = tid >> 3, c = tid & 7; const LAS float* s = scr + (8 * c) * 65 + n;
    u32x4 o; o.x = pk2(s[0], s[65]); o.y = pk2(s[130], s[195]); o.z = pk2(s[260], s[325]); o.w = pk2(s[390], s[455]);
    *(u32x4*)(WT + (size_t)(n0 + n) * K + k0 + 8 * c) = o;
    __syncthreads();
}

constexpr int NR = 3;
struct RowPtrs { const float* srcf; const u16* srcb; const void* resid; void* xout; u16* hout; bool parts4; };
template <int RB, int XB>
__device__ __forceinline__ void row_op2(const RowPtrs (&r)[NR], bool has_src, const float* gpost, const float* gnext, int lane) {
    f32x4 x[NR][4], s[NR][4];
#pragma unroll
    for (int k = 0; k < NR; ++k)
#pragma unroll
        for (int j = 0; j < 4; ++j) {
            if (RB) { const u32x2 wv = ((const u32x2*)r[k].resid)[lane + 64 * j]; x[k][j] = (f32x4){bf2f(wv.x & 0xffffu), bf2f(wv.x >> 16), bf2f(wv.y & 0xffffu), bf2f(wv.y >> 16)}; }
            else x[k][j] = ((const f32x4*)r[k].resid)[lane + 64 * j]; }
    if (has_src) {
        u32x2 sb[NR][4];
#pragma unroll
        for (int k = 0; k < NR; ++k)
#pragma unroll
            for (int j = 0; j < 4; ++j) {
                if (r[k].srcf != nullptr) { const float* sf = r[k].srcf; s[k][j] = ((const f32x4*)sf)[lane + 64 * j];
                    if (r[k].parts4) s[k][j] = (s[k][j] + ((const f32x4*)(sf + (size_t)TS * D))[lane + 64 * j]) + (((const f32x4*)(sf + (size_t)2 * TS * D))[lane + 64 * j] + ((const f32x4*)(sf + (size_t)3 * TS * D))[lane + 64 * j]); }
                else sb[k][j] = ((const u32x2*)r[k].srcb)[lane + 64 * j];
            }
        float ss[NR];
#pragma unroll
        for (int k = 0; k < NR; ++k) { ss[k] = 0.f;
#pragma unroll
            for (int j = 0; j < 4; ++j) {
                if (r[k].srcf == nullptr) { const u32x2 w = sb[k][j]; s[k][j] = (f32x4){bf2f(w.x & 0xffffu), bf2f(w.x >> 16), bf2f(w.y & 0xffffu), bf2f(w.y >> 16)}; }
                ss[k] += (s[k][j].x * s[k][j].x + s[k][j].y * s[k][j].y) + (s[k][j].z * s[k][j].z + s[k][j].w * s[k][j].w); } }
#pragma unroll
        for (int o = 1; o < 64; o <<= 1) {
#pragma unroll
            for (int k = 0; k < NR; ++k) ss[k] += __shfl_xor(ss[k], o); }
#pragma unroll
        for (int k = 0; k < NR; ++k) { const float rs = rsqrtf(ss[k] * (1.f / D) + EPS);
#pragma unroll
            for (int j = 0; j < 4; ++j) { const f32x4 g = ((const f32x4*)gpost)[lane + 64 * j]; x[k][j] = x[k][j] + s[k][j] * rs * g; } }
    }
#pragma unroll
    for (int k = 0; k < NR; ++k)
        if (r[k].xout != nullptr) {
#pragma unroll
            for (int j = 0; j < 4; ++j) {
                if (XB) { u32x2 wv; wv.x = pk2(x[k][j].x, x[k][j].y); wv.y = pk2(x[k][j].z, x[k][j].w); ((u32x2*)r[k].xout)[lane + 64 * j] = wv; }
                else ((f32x4*)r[k].xout)[lane + 64 * j] = x[k][j]; }
        }
    if (gnext != nullptr) {
        float ss[NR];
#pragma unroll
        for (int k = 0; k < NR; ++k) { ss[k] = 0.f;
#pragma unroll
            for (int j = 0; j < 4; ++j) ss[k] += (x[k][j].x * x[k][j].x + x[k][j].y * x[k][j].y) + (x[k][j].z * x[k][j].z + x[k][j].w * x[k][j].w); }
#pragma unroll
        for (int o = 1; o < 64; o <<= 1) {
#pragma unroll
            for (int k = 0; k < NR; ++k) ss[k] += __shfl_xor(ss[k], o); }
#pragma unroll
        for (int k = 0; k < NR; ++k) { const float rs = rsqrtf(ss[k] * (1.f / D) + EPS);
#pragma unroll
            for (int j = 0; j < 4; ++j) { const f32x4 g = ((const f32x4*)gnext)[lane + 64 * j]; const f32x4 h = x[k][j] * rs * g;
                u32x2 w; w.x = pk2(h.x, h.y); w.y = pk2(h.z, h.w); ((u32x2*)r[k].hout)[lane + 64 * j] = w; } }
    }
}

struct FinPtrs { const u16* peb; const u16* glb; const float* pes; const float* gls; const u16* xin; float* yout; };
__device__ __forceinline__ void row_final2(const FinPtrs (&r)[NR], const float* g, int lane) {
    f32x4 z[NR][4], x[NR][4]; u32x2 ra[NR][4], rb[NR][4]; float ss[NR];
#pragma unroll
    for (int k = 0; k < NR; ++k)
#pragma unroll
        for (int j = 0; j < 4; ++j) { { const u32x2 wv = ((const u32x2*)r[k].xin)[lane + 64 * j]; x[k][j] = (f32x4){bf2f(wv.x & 0xffffu), bf2f(wv.x >> 16), bf2f(wv.y & 0xffffu), bf2f(wv.y >> 16)}; }
            ra[k][j] = ((const u32x2*)r[k].peb)[lane + 64 * j]; if (r[k].gls == nullptr) rb[k][j] = ((const u32x2*)r[k].glb)[lane + 64 * j]; }
#pragma unroll
    for (int k = 0; k < NR; ++k) { ss[k] = 0.f;
#pragma unroll
        for (int j = 0; j < 4; ++j) {
            f32x4 pe, gl;
            { const u32x2 a = ra[k][j]; pe = (f32x4){bf2f(a.x & 0xffffu), bf2f(a.x >> 16), bf2f(a.y & 0xffffu), bf2f(a.y >> 16)}; }
            if (r[k].gls == nullptr) { const u32x2 b = rb[k][j]; gl = (f32x4){bf2f(b.x & 0xffffu), bf2f(b.x >> 16), bf2f(b.y & 0xffffu), bf2f(b.y >> 16)}; }
            else { const float* gls = r[k].gls;
                gl = (((const f32x4*)gls)[lane + 64 * j] + ((const f32x4*)(gls + (size_t)TS * D))[lane + 64 * j]) + (((const f32x4*)(gls + (size_t)2 * TS * D))[lane + 64 * j] + ((const f32x4*)(gls + (size_t)3 * TS * D))[lane + 64 * j]); }
            z[k][j] = (f32x4){pe.x * sigmoidf_(gl.x), pe.y * sigmoidf_(gl.y), pe.z * sigmoidf_(gl.z), pe.w * sigmoidf_(gl.w)};
            ss[k] += (z[k][j].x * z[k][j].x + z[k][j].y * z[k][j].y) + (z[k][j].z * z[k][j].z + z[k][j].w * z[k][j].w);
        } }
#pragma unroll
    for (int o = 1; o < 64; o <<= 1) {
#pragma unroll
            for (int k = 0; k < NR; ++k) ss[k] += __shfl_xor(ss[k], o); }
#pragma unroll
    for (int k = 0; k < NR; ++k) { const float rs = rsqrtf(ss[k] * (1.f / D) + EPS);
#pragma unroll
        for (int j = 0; j < 4; ++j) { const f32x4 gv = ((const f32x4*)g)[lane + 64 * j]; ((f32x4*)r[k].yout)[lane + 64 * j] = x[k][j] + z[k][j] * rs * gv; } }
}

#define LBAR() do { asm volatile("s_waitcnt lgkmcnt(0)" ::: "memory"); __builtin_amdgcn_s_barrier(); asm volatile("" ::: "memory"); } while (0)

constexpr int LD = 72;
__device__ __forceinline__ bf16x8 frag(const LAS u16* arr, int row0, int ld, int k0, int lane) { return *(const LAS bf16x8*)(arr + (row0 + (lane & 15)) * ld + k0 + (lane >> 4) * 8); }
__device__ __forceinline__ f32x4 mma16(bf16x8 a, bf16x8 b, f32x4 c) { return __builtin_amdgcn_mfma_f32_16x16x32_bf16(a, b, c, 0, 0, 0); }

struct GateW { float wg[16]; float bgd; int h; };
constexpr int RP = 132;
__device__ __forceinline__ bf16x8 gfrag(const LAS u16* arr, int pitch, int k0, int col, int lane) {
    const LAS u16* p = arr + (k0 + (lane >> 4) * 8) * pitch + col;
    bf16x8 r;
#pragma unroll
    for (int j = 0; j < 8; ++j) r[j] = (short)p[j * pitch];
    return r;
}
template <int MODE>
__device__ __forceinline__ void gla_chunk_item(int item, const u16* PROJ, u16* MIXIN, const float* wgate, const float* bgate, const float* ggla, float* GS, float* GDEC, const u16* GSB, LAS unsigned char* lds, GateW& gw_) {
    const int tid = threadIdx.x, lane = tid & 63, w = __builtin_amdgcn_readfirstlane(tid >> 6);
    const int nh = item >> 5, c = item & 31, n = nh >> 2, h = nh & 3;
    LAS u16* Qt = (LAS u16*)lds;
    LAS u16* Kt = Qt + 64 * LD;
    LAS u16* KdT = Kt + 64 * LD;
    LAS u16* Pm = KdT + 64 * LD;
    LAS u16* RQ = Pm + 64 * LD;
    LAS u16* RK = RQ + 64 * 64;
    LAS u16* RV = RK + 64 * 64;
    LAS u16* SN = RV + 64 * RP;
    LAS float* GLR = (LAS float*)(SN + 64 * RP);
    LAS float* SEG = GLR + 64 * 16;
    LAS float* SSQ = SEG + 8 * 64;
    const int d = lane, seg = w;
    const size_t row0 = (size_t)n * 2048 + c * 64;
    float* gs = GS + (size_t)item * 8192;
    if (h != gw_.h) {
#pragma unroll
        for (int r = 0; r < 16; ++r) gw_.wg[r] = wgate[r * 256 + h * 64 + d];
        gw_.bgd = bgate[h * 64 + d]; gw_.h = h;
    }
    const int qt_ = tid >> 3, qd_ = (tid & 7) * 8;
    const int vt_ = tid >> 4, ve_ = (tid & 15) * 8;
    u32x4 qraw, kraw, vraw0, vraw1, sraw[2];
    if (MODE == 1) qraw = *(const u32x4*)(PROJ + (row0 + qt_) * NPROJ + C_Q + h * 64 + qd_);
    kraw = *(const u32x4*)(PROJ + (row0 + qt_) * NPROJ + C_K + h * 64 + qd_);
    vraw0 = *(const u32x4*)(PROJ + (row0 + vt_) * NPROJ + C_V + h * 128 + ve_);
    vraw1 = *(const u32x4*)(PROJ + (row0 + 32 + vt_) * NPROJ + C_V + h * 128 + ve_);
    const unsigned glr = *(const unsigned*)(PROJ + (row0 + seg * 8 + (lane >> 3)) * NPROJ + C_GLR + (lane & 7) * 2);
    if (MODE == 1) {
#pragma unroll
        for (int i = 0; i < 2; ++i) sraw[i] = ((const u32x4*)(GSB + (size_t)item * 8192))[tid + 512 * i];
    }
    GLR[(seg * 8 + (lane >> 3)) * 16 + (lane & 7) * 2] = bf2f(glr & 0xffffu);
    GLR[(seg * 8 + (lane >> 3)) * 16 + (lane & 7) * 2 + 1] = bf2f(glr >> 16);
    float bl[8], run = 0.f;
#pragma unroll
    for (int tt = 0; tt < 8; ++tt) {
        const LAS f32x4* gp = (const LAS f32x4*)(GLR + (seg * 8 + tt) * 16);
        float logit = gw_.bgd;
#pragma unroll
        for (int r4 = 0; r4 < 4; ++r4) { const f32x4 gv = gp[r4]; logit += gv.x * gw_.wg[4 * r4] + gv.y * gw_.wg[4 * r4 + 1] + gv.z * gw_.wg[4 * r4 + 2] + gv.w * gw_.wg[4 * r4 + 3]; }
        run += logsig(logit) * (1.f / 16.f); bl[tt] = run;
    }
    SEG[seg * 64 + d] = run;
    if (MODE == 1) *(LAS u32x4*)(RQ + qt_ * 64 + qd_) = qraw;
    *(LAS u32x4*)(RK + qt_ * 64 + qd_) = kraw;
    *(LAS u32x2*)(RV + vt_ * RP + ve_) = (u32x2){vraw0.x, vraw0.y}; *(LAS u32x2*)(RV + vt_ * RP + ve_ + 4) = (u32x2){vraw0.z, vraw0.w};
    *(LAS u32x2*)(RV + (32 + vt_) * RP + ve_) = (u32x2){vraw1.x, vraw1.y}; *(LAS u32x2*)(RV + (32 + vt_) * RP + ve_ + 4) = (u32x2){vraw1.z, vraw1.w};
    if (MODE == 1) {
#pragma unroll
        for (int i = 0; i < 2; ++i) { const int idx = tid + 512 * i; LAS u16* sp_ = SN + (idx >> 4) * RP + (idx & 15) * 8;
            *(LAS u32x2*)sp_ = (u32x2){sraw[i].x, sraw[i].y}; *(LAS u32x2*)(sp_ + 4) = (u32x2){sraw[i].z, sraw[i].w}; }
    }
    LBAR();
    float off = 0.f, tot = 0.f;
#pragma unroll
    for (int s = 0; s < 8; ++s) { const float v = SEG[s * 64 + d]; tot += v; off += (s < seg) ? v : 0.f; }
    if (MODE == 0) {
        float kd[8];
#pragma unroll
        for (int tt = 0; tt < 8; ++tt) kd[tt] = bf2f(RK[(seg * 8 + tt) * 64 + d]) * __expf(tot - (off + bl[tt]));
        u32x4 kk; kk.x = pk2(kd[0], kd[1]); kk.y = pk2(kd[2], kd[3]); kk.z = pk2(kd[4], kd[5]); kk.w = pk2(kd[6], kd[7]);
        *(LAS u32x4*)(KdT + d * LD + seg * 8) = kk;
        if (seg == 0) GDEC[(size_t)item * 64 + d] = __expf(tot);
        LBAR();
        const bf16x8 av0 = gfrag(RV, RP, 0, 16 * w + (lane & 15), lane), av1 = gfrag(RV, RP, 32, 16 * w + (lane & 15), lane);
#pragma unroll
        for (int dt = 0; dt < 4; ++dt) { f32x4 s = (f32x4){0.f, 0.f, 0.f, 0.f};
            s = mma16(av0, frag(KdT, dt * 16, LD, 0, lane), s); s = mma16(av1, frag(KdT, dt * 16, LD, 32, lane), s);
            *(f32x4*)(gs + (size_t)(16 * dt + (lane & 15)) * 128 + 16 * w + (lane >> 4) * 4) = s; }
        LBAR();
    } else {
#pragma unroll
        for (int tt = 0; tt < 8; ++tt) {
            const int i = seg * 8 + tt;
            const float b = off + bl[tt], q = bf2f(RQ[i * 64 + d]), k = bf2f(RK[i * 64 + d]);
            const float qv = q * 0.125f * __expf(b), kv = k * __expf(-b);
            Qt[i * LD + d] = (u16)(pk2(qv, 0.f) & 0xffffu); Kt[i * LD + d] = (u16)(pk2(kv, 0.f) & 0xffffu);
        }
        const int e4 = 16 * w + (lane >> 4) * 4;
        const f32x4 gg = *(const f32x4*)(ggla + e4);
        u32x2 rw[4];
#pragma unroll
        for (int it = 0; it < 4; ++it) rw[it] = *(const u32x2*)(PROJ + (row0 + it * 16 + (lane & 15)) * NPROJ + C_R + h * 128 + e4);
        LBAR();
        {
            const int it = w >> 1; const bf16x8 bq0 = frag(Qt, it * 16, LD, 0, lane), bq1 = frag(Qt, it * 16, LD, 32, lane);
#pragma unroll
            for (int jj = 0; jj < 2; ++jj) { const int jt = 2 * (w & 1) + jj;
                f32x4 p = (f32x4){0.f, 0.f, 0.f, 0.f};
                p = mma16(frag(Kt, jt * 16, LD, 0, lane), bq0, p); p = mma16(frag(Kt, jt * 16, LD, 32, lane), bq1, p);
                const int i = it * 16 + (lane & 15), j0 = jt * 16 + (lane >> 4) * 4;
                u32x2 pv; pv.x = pk2(j0 <= i ? p.x : 0.f, j0 + 1 <= i ? p.y : 0.f); pv.y = pk2(j0 + 2 <= i ? p.z : 0.f, j0 + 3 <= i ? p.w : 0.f);
                *(LAS u32x2*)(Pm + i * LD + j0) = pv; }
        }
        LBAR();
        f32x4 o[4];
        {
            const int ec = 16 * w + (lane & 15);
            const bf16x8 as0 = gfrag(SN, RP, 0, ec, lane), as1 = gfrag(SN, RP, 32, ec, lane), av0 = gfrag(RV, RP, 0, ec, lane), av1 = gfrag(RV, RP, 32, ec, lane);
#pragma unroll
            for (int it = 0; it < 4; ++it) { f32x4 a = (f32x4){0.f, 0.f, 0.f, 0.f};
                a = mma16(as0, frag(Qt, it * 16, LD, 0, lane), a); a = mma16(as1, frag(Qt, it * 16, LD, 32, lane), a);
                a = mma16(av0, frag(Pm, it * 16, LD, 0, lane), a); a = mma16(av1, frag(Pm, it * 16, LD, 32, lane), a); o[it] = a; }
        }
#pragma unroll
        for (int it = 0; it < 4; ++it) { float s = o[it].x * o[it].x + o[it].y * o[it].y + o[it].z * o[it].z + o[it].w * o[it].w;
            s += __shfl_xor(s, 16); s += __shfl_xor(s, 32);
            if (lane < 16) SSQ[(it * 16 + lane) * 8 + w] = s; }
        LBAR();
#pragma unroll
        for (int it = 0; it < 4; ++it) { const int i = it * 16 + (lane & 15);
            const f32x4 s0 = *(const LAS f32x4*)(SSQ + i * 8), s1 = *(const LAS f32x4*)(SSQ + i * 8 + 4);
            const float rs = rsqrtf(((s0.x + s0.y) + (s0.z + s0.w) + (s1.x + s1.y) + (s1.z + s1.w)) * (1.f / 128.f) + EPS);
            const size_t row = row0 + i;
            const float r0 = bf2f(rw[it].x & 0xffffu), r1 = bf2f(rw[it].x >> 16), r2 = bf2f(rw[it].y & 0xffffu), r3 = bf2f(rw[it].y >> 16);
            u32x2 ov; ov.x = pk2(o[it].x * rs * gg.x * r0 * sigmoidf_(r0), o[it].y * rs * gg.y * r1 * sigmoidf_(r1));
            ov.y = pk2(o[it].z * rs * gg.z * r2 * sigmoidf_(r2), o[it].w * rs * gg.w * r3 * sigmoidf_(r3));
            *(u32x2*)(MIXIN + row * D + h * 128 + e4) = ov; }
        LBAR();
    }
}

__device__ __forceinline__ void gla_scan(int gid, const float* GS, u16* GSB, const float* GDEC, float* out_state) {
    const int nh = gid >> 12, rem = gid & 4095, d = rem >> 6, e2 = (rem & 63) * 2;
    const float* gp = GS + (size_t)nh * 32 * 8192 + d * 128 + e2;
    u16* bp = GSB + (size_t)nh * 32 * 8192 + d * 128 + e2;
    const float* dp = GDEC + (size_t)nh * 32 * 64 + d;
    f32x2 S = (f32x2){0.f, 0.f};
    {
        f32x2 ds[32]; float dc[32];
#pragma unroll
        for (int j = 0; j < 32; ++j) { ds[j] = *(const f32x2*)(gp + (size_t)j * 8192); dc[j] = dp[j * 64]; }
#pragma unroll
        for (int j = 0; j < 32; ++j) { *(unsigned*)(bp + (size_t)j * 8192) = pk2(S.x, S.y); S = S * dc[j] + ds[j]; }
    }
    *(f32x2*)(out_state + ((size_t)nh * 64 + d) * 128 + e2) = S;
}

constexpr int LD2 = 136;
__device__ __forceinline__ void sgu_prompt_item(int item, const u16* PROJ, u16* MIXIN, const float* gln, const float* bln, const float* wsp, const float* bsp, LAS unsigned char* lds, int& hh_cached) {
    const int tid = threadIdx.x, lane = tid & 63, w = __builtin_amdgcn_readfirstlane(tid >> 6);
    const int hh = item & 3, cc = (item >> 2) & 15, n = item >> 6;
    const size_t row0 = (size_t)n * 2048 + cc * 128;
    LAS u16* VnT = (LAS u16*)lds;
    LAS u16* Wm = VnT + 128 * LD2;
    LAS u16* RAW = Wm + 128 * LD2;
    LAS float* STAT = (LAS float*)(RAW + 128 * LD2);
    u32x4 rv[4];
#pragma unroll
    for (int i = 0; i < 4; ++i) { const int idx = tid + 512 * i, s = idx >> 4, ch = (idx & 15) * 8; rv[i] = *(const u32x4*)(PROJ + (row0 + s) * NPROJ + C_VS + hh * 128 + ch); }
    u32x2 uw[8];
#pragma unroll
    for (int dct = 0; dct < 8; ++dct) uw[dct] = *(const u32x2*)(PROJ + (row0 + 16 * w + (lane & 15)) * NPROJ + C_U + hh * 128 + 16 * dct + (lane >> 4) * 4);
    const float bs = bsp[hh * 128 + 16 * w + (lane & 15)];
    if (hh != hh_cached) {
        const int t = tid >> 2, s0 = (tid & 3) * 32; const float* wp = wsp + ((size_t)hh * 128 + t) * 128 + s0;
#pragma unroll
        for (int q = 0; q < 4; ++q) { const f32x4 a = *(const f32x4*)(wp + 8 * q), b = *(const f32x4*)(wp + 8 * q + 4); const int s = s0 + 8 * q;
            u32x4 o; o.x = pk2(s <= t ? a.x : 0.f, s + 1 <= t ? a.y : 0.f); o.y = pk2(s + 2 <= t ? a.z : 0.f, s + 3 <= t ? a.w : 0.f);
            o.z = pk2(s + 4 <= t ? b.x : 0.f, s + 5 <= t ? b.y : 0.f); o.w = pk2(s + 6 <= t ? b.z : 0.f, s + 7 <= t ? b.w : 0.f);
            *(LAS u32x4*)(Wm + t * LD2 + s) = o; }
        hh_cached = hh;
    }
#pragma unroll
    for (int i = 0; i < 4; ++i) { const int idx = tid + 512 * i, s = idx >> 4, ch = (idx & 15) * 8; *(LAS u32x4*)(RAW + s * LD2 + ch) = rv[i]; }
    LBAR();
    { const int s = tid >> 2, qd = tid & 3; float s1 = 0.f, s2 = 0.f;
#pragma unroll
      for (int i = 0; i < 4; ++i) { const u32x4 r = *(const LAS u32x4*)(RAW + s * LD2 + qd * 32 + 8 * i);
          const unsigned ww[4] = {r.x, r.y, r.z, r.w};
#pragma unroll
          for (int k = 0; k < 4; ++k) { const float a = bf2f(ww[k] & 0xffffu), b = bf2f(ww[k] >> 16); s1 += a + b; s2 += a * a + b * b; } }
      s1 += __shfl_xor(s1, 1); s2 += __shfl_xor(s2, 1); s1 += __shfl_xor(s1, 2); s2 += __shfl_xor(s2, 2);
      const float mu = s1 * (1.f / 128.f), var = fmaxf(s2 * (1.f / 128.f) - mu * mu, 0.f);
      if (qd == 0) { STAT[2 * s] = mu; STAT[2 * s + 1] = rsqrtf(var + EPS); } }
    LBAR();
    { const int dc = tid & 127, sg = tid >> 7; const float g = gln[hh * 128 + dc], b = bln[hh * 128 + dc];
#pragma unroll
      for (int i = 0; i < 4; ++i) { const int s0 = sg * 32 + i * 8; float v[8];
#pragma unroll
          for (int j = 0; j < 8; ++j) { const f32x2 st = *(const LAS f32x2*)(STAT + 2 * (s0 + j)); v[j] = (bf2f(RAW[(s0 + j) * LD2 + dc]) - st.x) * st.y * g + b; }
          u32x4 o; o.x = pk2(v[0], v[1]); o.y = pk2(v[2], v[3]); o.z = pk2(v[4], v[5]); o.w = pk2(v[6], v[7]);
          *(LAS u32x4*)(VnT + dc * LD2 + s0) = o; } }
    LBAR();
    f32x4 acc[8];
#pragma unroll
    for (int dct = 0; dct < 8; ++dct) acc[dct] = (f32x4){0.f, 0.f, 0.f, 0.f};
    for (int ks = 0; ks <= (w >> 1); ++ks) { const bf16x8 b = frag(Wm, 16 * w, LD2, ks * 32, lane);
#pragma unroll
        for (int dct = 0; dct < 8; ++dct) acc[dct] = mma16(frag(VnT, dct * 16, LD2, ks * 32, lane), b, acc[dct]); }
    { const int t = 16 * w + (lane & 15); const size_t row = row0 + t;
#pragma unroll
      for (int dct = 0; dct < 8; ++dct) { const int dc = 16 * dct + (lane >> 4) * 4;
          u32x2 ov; ov.x = pk2(bf2f(uw[dct].x & 0xffffu) * (acc[dct].x + bs), bf2f(uw[dct].x >> 16) * (acc[dct].y + bs));
          ov.y = pk2(bf2f(uw[dct].y & 0xffffu) * (acc[dct].z + bs), bf2f(uw[dct].y >> 16) * (acc[dct].w + bs));
          *(u32x2*)(MIXIN + row * D + 512 + hh * 128 + dc) = ov; } }
    LBAR();
}

__device__ __forceinline__ void gla_sample_item(int nh, const u16* PROJ, u16* MIXIN, const float* wgate, const float* bgate, const float* ggla, const float* state_in, float* state_out, LAS unsigned char* lds) {
    const int tid = threadIdx.x, lane = tid & 63, w = __builtin_amdgcn_readfirstlane(tid >> 6), n = nh >> 2, h = nh & 3;
    LAS float* AKQ = (LAS float*)lds;
    LAS float* PO = AKQ + 4 * 3 * 64;
    LAS float* SS = PO + 4 * 4 * 128;
    const int e = tid & 127, dq = w >> 1;
    float S[16];
    const float* sp = state_in + ((size_t)nh * 64 + dq * 16) * 128 + e;
#pragma unroll
    for (int i = 0; i < 16; ++i) S[i] = sp[i * 128];
    if (tid < 256) {
        const int t = tid >> 6, d = tid & 63;
        const u16* pr = PROJ + ((size_t)TP + n * 4 + t) * NPROJ;
        const u32x4 ga = *(const u32x4*)(pr + C_GLR), gb = *(const u32x4*)(pr + C_GLR + 8);
        const float* wgp = wgate + h * 64 + d;
        float logit = bgate[h * 64 + d];
        logit += bf2f(ga.x & 0xffffu) * wgp[0] + bf2f(ga.x >> 16) * wgp[256] + bf2f(ga.y & 0xffffu) * wgp[512] + bf2f(ga.y >> 16) * wgp[768];
        logit += bf2f(ga.z & 0xffffu) * wgp[1024] + bf2f(ga.z >> 16) * wgp[1280] + bf2f(ga.w & 0xffffu) * wgp[1536] + bf2f(ga.w >> 16) * wgp[1792];
        logit += bf2f(gb.x & 0xffffu) * wgp[2048] + bf2f(gb.x >> 16) * wgp[2304] + bf2f(gb.y & 0xffffu) * wgp[2560] + bf2f(gb.y >> 16) * wgp[2816];
        logit += bf2f(gb.z & 0xffffu) * wgp[3072] + bf2f(gb.z >> 16) * wgp[3328] + bf2f(gb.w & 0xffffu) * wgp[3584] + bf2f(gb.w >> 16) * wgp[3840];
        AKQ[(t * 3 + 0) * 64 + d] = __expf(logsig(logit) * (1.f / 16.f));
        AKQ[(t * 3 + 1) * 64 + d] = bf2f(pr[C_K + h * 64 + d]);
        AKQ[(t * 3 + 2) * 64 + d] = bf2f(pr[C_Q + h * 64 + d]) * 0.125f;
    }
    LBAR();
#pragma unroll
    for (int t = 0; t < 4; ++t) {
        const float v = bf2f(PROJ[((size_t)TP + n * 4 + t) * NPROJ + C_V + h * 128 + e]);
        float po = 0.f;
#pragma unroll
        for (int i4 = 0; i4 < 4; ++i4) {
            const f32x4 a = *(const LAS f32x4*)(AKQ + (t * 3 + 0) * 64 + dq * 16 + 4 * i4), k = *(const LAS f32x4*)(AKQ + (t * 3 + 1) * 64 + dq * 16 + 4 * i4), q = *(const LAS f32x4*)(AKQ + (t * 3 + 2) * 64 + dq * 16 + 4 * i4);
            S[4 * i4 + 0] = a.x * S[4 * i4 + 0] + k.x * v; po += q.x * S[4 * i4 + 0];
            S[4 * i4 + 1] = a.y * S[4 * i4 + 1] + k.y * v; po += q.y * S[4 * i4 + 1];
            S[4 * i4 + 2] = a.z * S[4 * i4 + 2] + k.z * v; po += q.z * S[4 * i4 + 2];
            S[4 * i4 + 3] = a.w * S[4 * i4 + 3] + k.w * v; po += q.w * S[4 * i4 + 3];
        }
        PO[(t * 4 + dq) * 128 + e] = po;
    }
    float* so = state_out + ((size_t)nh * 64 + dq * 16) * 128 + e;
#pragma unroll
    for (int i = 0; i < 16; ++i) so[i * 128] = S[i];
    LBAR();
    const int t2 = w >> 1, e2 = (w & 1) * 64 + lane;
    const float o = (PO[(t2 * 4 + 0) * 128 + e2] + PO[(t2 * 4 + 1) * 128 + e2]) + (PO[(t2 * 4 + 2) * 128 + e2] + PO[(t2 * 4 + 3) * 128 + e2]);
    const float part = wave_sum(o * o);
    if (lane == 0) SS[w] = part;
    LBAR();
    const float rs = rsqrtf((SS[2 * t2] + SS[2 * t2 + 1]) * (1.f / 128.f) + EPS);
    const size_t row = (size_t)TP + n * 4 + t2;
    const float r = bf2f(PROJ[row * NPROJ + C_R + h * 128 + e2]);
    MIXIN[row * D + h * 128 + e2] = (u16)(pk2(o * rs * ggla[e2] * r * sigmoidf_(r), 0.f) & 0xffffu);
    LBAR();
}

__device__ __forceinline__ void sgu_sample_item(int item, const u16* PROJ, u16* MIXIN, const float* gln, const float* bln, const float* wsp, const float* bsp, float* vout, int lane) {
    const int n = item >> 2, hh = item & 3; const int c0 = hh * 128 + 2 * lane;
    const float g0 = gln[c0], g1 = gln[c0 + 1], b0 = bln[c0], b1 = bln[c0 + 1];
    float vn0[4], vn1[4];
#pragma unroll
    for (int t = 0; t < 4; ++t) { const size_t row = (size_t)TP + n * 4 + t; const unsigned raw = *(const unsigned*)(PROJ + row * NPROJ + C_VS + c0);
        const float x0 = bf2f(raw & 0xffffu), x1 = bf2f(raw >> 16);
        const float mu = wave_sum(x0 + x1) * (1.f / 128.f), d0 = x0 - mu, d1 = x1 - mu;
        const float rstd = rsqrtf(wave_sum(d0 * d0 + d1 * d1) * (1.f / 128.f) + EPS);
        vn0[t] = d0 * rstd * g0 + b0; vn1[t] = d1 * rstd * g1 + b1;
        *(f32x2*)(vout + ((size_t)n * 4 + t) * 512 + c0) = (f32x2){vn0[t], vn1[t]}; }
#pragma unroll
    for (int t = 0; t < 4; ++t) { const size_t row = (size_t)TP + n * 4 + t; float m0 = bsp[hh * 128 + t], m1 = m0;
#pragma unroll
        for (int s = 0; s < 4; ++s) if (s <= t) { const float wv = wsp[((size_t)hh * 128 + t) * 128 + s]; m0 += wv * vn0[s]; m1 += wv * vn1[s]; }
        const unsigned uw = *(const unsigned*)(PROJ + row * NPROJ + C_U + c0);
        *(unsigned*)(MIXIN + row * D + 512 + c0) = pk2(bf2f(uw & 0xffffu) * m0, bf2f(uw >> 16) * m1); }
}

__device__ __forceinline__ void act_item(int item, u16* UP, const u16* HALO, const float* sconv, const float* wconv, const float* bconv, float* out, int lane) {
    const int rb = item / 22, cch = item - rb * 22, j0 = cch * 128 + 2 * lane;
    float wgt[3][2], wvl[3][2], bg[2], bv[2];
#pragma unroll
    for (int k = 0; k < 3; ++k) { const f32x2 a = *(const f32x2*)(wconv + k * FF2 + j0), b = *(const f32x2*)(wconv + k * FF2 + FF + j0); wgt[k][0] = a.x; wgt[k][1] = a.y; wvl[k][0] = b.x; wvl[k][1] = b.y; }
    { const f32x2 a = *(const f32x2*)(bconv + j0), b = *(const f32x2*)(bconv + FF + j0); bg[0] = a.x; bg[1] = a.y; bv[0] = b.x; bv[1] = b.y; }
    const bool sample = rb >= 256;
    float g2[2] = {0.f, 0.f}, g1[2] = {0.f, 0.f}, v2[2] = {0.f, 0.f}, v1[2] = {0.f, 0.f};
    if (!sample && (rb & 31) != 0) {
        const unsigned a = *(const unsigned*)(HALO + (size_t)((rb - 1) * 2) * FF2 + j0), b = *(const unsigned*)(HALO + (size_t)((rb - 1) * 2) * FF2 + FF + j0);
        const unsigned c = *(const unsigned*)(HALO + (size_t)((rb - 1) * 2 + 1) * FF2 + j0), dd = *(const unsigned*)(HALO + (size_t)((rb - 1) * 2 + 1) * FF2 + FF + j0);
        g2[0] = bf2f(a & 0xffffu); g2[1] = bf2f(a >> 16); v2[0] = bf2f(b & 0xffffu); v2[1] = bf2f(b >> 16);
        g1[0] = bf2f(c & 0xffffu); g1[1] = bf2f(c >> 16); v1[0] = bf2f(dd & 0xffffu); v1[1] = bf2f(dd >> 16);
    }
    for (int tb = 0; tb < 64; tb += 16) {
        unsigned gw[16], vw[16];
#pragma unroll
        for (int t = 0; t < 16; ++t) { const size_t row = (size_t)rb * 64 + tb + t; gw[t] = *(const unsigned*)(UP + row * FF2 + j0); vw[t] = *(const unsigned*)(UP + row * FF2 + FF + j0); }
#pragma unroll
        for (int t = 0; t < 16; ++t) {
            const int row = rb * 64 + tb + t;
            if (sample && (t & 3) == 0) { const int ns = (row - TP) >> 2; const float* s0 = sconv + (size_t)ns * 2 * FF2;
                const f32x2 a = *(const f32x2*)(s0 + j0), b = *(const f32x2*)(s0 + FF + j0), c = *(const f32x2*)(s0 + FF2 + j0), dd = *(const f32x2*)(s0 + FF2 + FF + j0);
                g2[0] = a.x; g2[1] = a.y; v2[0] = b.x; v2[1] = b.y; g1[0] = c.x; g1[1] = c.y; v1[0] = dd.x; v1[1] = dd.y; }
            const float g0[2] = {bf2f(gw[t] & 0xffffu), bf2f(gw[t] >> 16)}, v0[2] = {bf2f(vw[t] & 0xffffu), bf2f(vw[t] >> 16)};
            float res[2];
#pragma unroll
            for (int p = 0; p < 2; ++p) { const float cgv = bg[p] + wgt[0][p] * g2[p] + wgt[1][p] * g1[p] + wgt[2][p] * g0[p];
                const float cvv = bv[p] + wvl[0][p] * v2[p] + wvl[1][p] * v1[p] + wvl[2][p] * v0[p]; res[p] = gelu_t(cgv) * cvv;
                g2[p] = g1[p]; g1[p] = g0[p]; v2[p] = v1[p]; v1[p] = v0[p]; }
            *(unsigned*)(UP + (size_t)row * FF2 + j0) = pk2(res[0], res[1]);
            if (!sample) { const int tq = row & 2047; if (tq >= 2046) { float* o = out + O_CONVP + ((size_t)(row >> 11) * 2 + (tq - 2046)) * FF2;
                    *(f32x2*)(o + j0) = (f32x2){g0[0], g0[1]}; *(f32x2*)(o + FF + j0) = (f32x2){v0[0], v0[1]}; } }
            else if ((t & 3) >= 2) { const int ns = (row - TP) >> 2; float* o = out + O_CONVS + ((size_t)ns * 2 + ((t & 3) - 2)) * FF2;
                    *(f32x2*)(o + j0) = (f32x2){g0[0], g0[1]}; *(f32x2*)(o + FF + j0) = (f32x2){v0[0], v0[1]}; }
        }
    }
}

__global__ void __launch_bounds__(512, 2) fwd_kernel(Args args) {
    extern __shared__ __attribute__((aligned(16))) unsigned char lds_raw[];
    LAS unsigned char* lds = (LAS unsigned char*)lds_raw;
    cg::grid_group grid = cg::this_grid();
    const int tid = threadIdx.x, lane = tid & 63, wave = __builtin_amdgcn_readfirstlane(tid >> 6);
    const int G = gridDim.x, bid = blockIdx.x, gw = bid * 8 + wave, NGW = G * 8;
    unsigned char* ws = args.ws; float* out = args.out;
    u16* WinT = (u16*)(ws + WS_WIN); u16* WoutT = (u16*)(ws + WS_WOUT); u16* WupT = (u16*)(ws + WS_WUP); u16* WdnT = (u16*)(ws + WS_WDN); u16* WpgT = (u16*)(ws + WS_WPG); u16* WpleT = (u16*)(ws + WS_WPLE);
    u16* H = (u16*)(ws + WS_H); u16* HALO = (u16*)(ws + WS_HALO); u16* X1B = (u16*)(out + O_Y);
    u16* PROJ = (u16*)(ws + WS_BIG); u16* UP = (u16*)(ws + WS_BIG); float* Z = (float*)(ws + WS_BIG);
    u16* MIXB = (u16*)(ws + WS_BIG2); u16* PB = (u16*)(ws + 9 * MiB);
    float* GLS = (float*)(ws + WS_WIN);
    float* FT3 = (float*)(ws + WS_BIG); float* FT7 = (float*)(ws + WS_WIN);
    const float* xp = args.in[I_XP]; const float* xs = args.in[I_XS];
    const int lo = args.ph_lo, hi = args.ph_hi;
#define IN(k) (lo <= (k) && (k) < hi)
    volatile LAS unsigned* MISC = (volatile LAS unsigned*)(lds + MISC_OFF);
    if (tid < 4) MISC[tid] = 0u;
    __syncthreads();
    XcdBarrier xbar = xcd_barrier_post((unsigned*)(ws + WS_CTL), MISC);
    if (lo < 0) grid.sync();
#define SYNC(k) do { if (IN(k) && IN((k) + 1)) xcd_barrier(xbar); } while (0)
#define IDLE_RANK(nun, rank, nidle) const int _f##rank = (nun) % G; const int rank = _f##rank ? bid - _f##rank : bid; const int nidle = _f##rank ? G - _f##rank : G;
#define XROW(m) ((m) < TP ? xp + (size_t)(m) * D : xs + (size_t)((m) - TP) * D)

    if (IN(0)) {
        LAS float* scr = (LAS float*)lds;
        constexpr int T_IN = 16 * 44, T_OUT = 16 * 16, T_UP = 16 * 88, T_DN = 44 * 16, T_PG = 16 * 16, T_PLE = 4 * 16, NT = T_IN + T_OUT + T_UP + T_DN + T_PG + T_PLE;
        (void)NT;
        for (int r = bid; r < T_IN; r += G) transpose_tile(args.in[I_WIN], D, NIN, WinT, (r / 44) * 64, (r % 44) * 64, scr, tid);
        for (int m0 = gw; m0 < T; m0 += NR * NGW) { RowPtrs r[NR];
#pragma unroll
            for (int k = 0; k < NR; ++k) { const int m = (m0 + k * NGW < T) ? m0 + k * NGW : m0; r[k] = RowPtrs{nullptr, nullptr, XROW(m), nullptr, H + (size_t)m * D, false}; }
            row_op2<0, 0>(r, false, nullptr, args.in[I_GMIXPRE], lane); }
    }
    SYNC(0);
    if (IN(1)) {
        pg8::Gemm g{H, WinT, T, NPROJ, D, D}; pg8::StaticOrder S; S.init(T, NPROJ, D, G, bid, 0, 1);
        pg8::EpiBf16 E{PROJ, NPROJ, nullptr, nullptr, 0, 0, D, C_U};
        pg8::gemm_phase<pg8::EpiBf16>(lds, g, S, E);
        { IDLE_RANK(66 * 11, rk, ni); LAS float* scr = (LAS float*)lds;
          if (rk >= 0) for (int r = rk; r < 16 * 16; r += ni) transpose_tile(args.in[I_WOUT], D, D, WoutT, (r / 16) * 64, (r % 16) * 64, scr, tid); }
    }
    SYNC(1);
    if (IN(2)) {
        u16* MIXIN = H; float* GS = (float*)(ws + WS_BIG2); float* GDEC = (float*)(ws + WS_BIG2 + 40 * MiB); u16* GSB = (u16*)(ws + WS_BIG2 + 48 * MiB);
        int hh_cached = -1;
        GateW gwt; gwt.h = -1; gwt.bgd = 0.f;
#pragma unroll
        for (int r = 0; r < 16; ++r) gwt.wg[r] = 0.f;
        for (int it = bid; it < 2048; it += G) {
            if (it < 512) sgu_prompt_item(it, PROJ, MIXIN, args.in[I_GSGULN], args.in[I_BSGULN], args.in[I_WSPAT], args.in[I_BSPAT], lds, hh_cached);
            else if (it < 1536) gla_chunk_item<0>(it - 512, PROJ, MIXIN, args.in[I_WGATE], args.in[I_BGATE], args.in[I_GGLAOUT], GS, GDEC, GSB, lds, gwt);
            else gla_sample_item(it - 1536, PROJ, MIXIN, args.in[I_WGATE], args.in[I_BGATE], args.in[I_GGLAOUT], args.in[I_SGLA], out + O_GLAS, lds);
        }
        for (int it = gw; it < 512; it += NGW) sgu_sample_item(it, PROJ, MIXIN, args.in[I_GSGULN], args.in[I_BSGULN], args.in[I_WSPAT], args.in[I_BSPAT], out + O_SGUV, lane);
        xcd_barrier(xbar);
        for (int gid = bid * 512 + tid; gid < 32 * 4096; gid += G * 512) gla_scan(gid, GS, GSB, GDEC, out + O_GLAP);
        xcd_barrier(xbar);
        for (int it = bid; it < 1024; it += G) gla_chunk_item<1>(it, PROJ, MIXIN, args.in[I_WGATE], args.in[I_BGATE], args.in[I_GGLAOUT], GS, GDEC, GSB, lds, gwt);
    }
    SYNC(2);
    if (IN(3)) {
        pg8::Gemm g{H, WoutT, T, D, D, D}; pg8::StaticOrder S; S.init(T, D, D, G, bid, 2, 4);
        pg8::EpiBf16 E{MIXB, D, nullptr, FT3, TP, (size_t)TS * D, D, 0x7fffffff};
        pg8::gemm_phase<pg8::EpiBf16>(lds, g, S, E);
        { const int f = (G > 32) ? 32 : 0, rk = bid - f, ni = G - f; LAS float* scr = (LAS float*)lds;
          if (rk >= 0) for (int r = rk; r < 16 * 88; r += ni) transpose_tile(args.in[I_WUP], D, FF2, WupT, (r / 88) * 64, (r % 88) * 64, scr, tid); }
    }
    SYNC(3);
    if (IN(4)) {
        for (int m0 = gw; m0 < T; m0 += NR * NGW) { RowPtrs r[NR];
#pragma unroll
            for (int k = 0; k < NR; ++k) { const int m = (m0 + k * NGW < T) ? m0 + k * NGW : m0;
                r[k] = RowPtrs{m < TP ? nullptr : FT3 + (size_t)(m - TP) * D, MIXB + (size_t)m * D, XROW(m), X1B + (size_t)m * D, H + (size_t)m * D, m >= TP}; }
            row_op2<0, 1>(r, true, args.in[I_GMIXPOST], args.in[I_GFFNPRE], lane); }
    }
    SYNC(4);
    if (IN(5)) {
        pg8::Gemm g{H, WupT, T, FF2, D, D}; pg8::StaticOrder S; S.init(T, FF2, D, G, bid, 0, 1);
        pg8::EpiBf16 E{UP, FF2, HALO, nullptr, 0, 0, D, 0x7fffffff};
        pg8::gemm_phase<pg8::EpiBf16>(lds, g, S, E);
        { IDLE_RANK(66 * 22, rk, ni); LAS float* scr = (LAS float*)lds;
          if (rk >= 0) for (int it = rk; it < 44 * 16 + 16 * 16 + 4 * 16; it += ni) { int r = it;
              if (r < 44 * 16) { transpose_tile(args.in[I_WDOWN], FF, D, WdnT, (r / 16) * 64, (r % 16) * 64, scr, tid); continue; } r -= 44 * 16;
              if (r < 16 * 16) { transpose_tile(args.in[I_WPG], D, D, WpgT, (r / 16) * 64, (r % 16) * 64, scr, tid); continue; } r -= 16 * 16;
              transpose_tile(args.in[I_WPLE], PLE, D, WpleT, (r / 16) * 64, (r % 16) * 64, scr, tid); } }
    }
    SYNC(5);
    if (IN(6)) {
        for (int it = gw; it < 264 * 22; it += NGW) act_item(it, UP, HALO, args.in[I_SCONV], args.in[I_WCONV], args.in[I_BCONV], out, lane);
        for (int m = gw; m < T; m += NGW) {
            const float* pp = (m < TP) ? args.in[I_PP] + (size_t)m * PLE : args.in[I_PS] + (size_t)(m - TP) * PLE;
            const f32x4 v = ((const f32x4*)pp)[lane]; u32x2 wv; wv.x = pk2(v.x, v.y); wv.y = pk2(v.z, v.w); ((u32x2*)(PB + (size_t)m * PLE))[lane] = wv; }
    }
    SYNC(6);
    if (IN(7)) {
        pg8::Gemm g{UP, WdnT, T, D, FF, FF2}; pg8::StaticOrder S; S.init(T, D, FF, G, bid, 2, 4);
        pg8::EpiBf16 E{H, D, nullptr, FT7, TP, (size_t)TS * D, D, 0x7fffffff};
        pg8::gemm_phase<pg8::EpiBf16>(lds, g, S, E);
        if (bid >= 32 && G > 32) {
            pg8::Gemm g2{PB, WpleT, T, D, PLE, PLE}; pg8::StaticOrder S2; S2.init(T, D, PLE, G - 32, bid - 32, 0, 1);
            pg8::EpiBf16 E2{UP + FF, FF2, nullptr, nullptr, 0, 0, D, 0x7fffffff};
            pg8::gemm_phase<pg8::EpiBf16>(lds, g2, S2, E2);
        }
    }
    SYNC(7);
    if (IN(8)) {
        for (int m0 = gw; m0 < T; m0 += NR * NGW) { RowPtrs r[NR];
#pragma unroll
            for (int k = 0; k < NR; ++k) { const int m = (m0 + k * NGW < T) ? m0 + k * NGW : m0;
                r[k] = RowPtrs{m < TP ? nullptr : FT7 + (size_t)(m - TP) * D, H + (size_t)m * D, X1B + (size_t)m * D, UP + (size_t)m * FF2, H + (size_t)m * D, m >= TP}; }
            row_op2<1, 1>(r, true, args.in[I_GFFNPOST], args.in[I_GPLEIN], lane); }
    }
    SYNC(8);
    if (IN(9)) {
        pg8::Gemm g{H, WpgT, T, D, D, D}; pg8::StaticOrder S; S.init(T, D, D, G, bid, 2, 4);
        pg8::EpiBf16 E{UP + FF + D, FF2, nullptr, GLS, TP, (size_t)TS * D, D, 0x7fffffff};
        pg8::gemm_phase<pg8::EpiBf16>(lds, g, S, E);
    }
    SYNC(9);
    if (IN(10)) {
        for (int m0 = gw; m0 < T; m0 += NR * NGW) { FinPtrs r[NR];
#pragma unroll
            for (int k = 0; k < NR; ++k) { const int m = (m0 + k * NGW < T) ? m0 + k * NGW : m0;
                r[k] = FinPtrs{UP + (size_t)m * FF2 + FF, UP + (size_t)m * FF2 + FF + D, nullptr, m < TP ? nullptr : GLS + (size_t)(m - TP) * D, UP + (size_t)m * FF2, out + O_Y + (size_t)m * D}; }
            row_final2(r, args.in[I_GPLEPOST], lane); }
    }
#undef IN
#undef SYNC
#undef XROW
}

#ifndef N_LAUNCH
#define N_LAUNCH 1
#endif
extern "C" void kernel_launch(void* const* d_in, const int* in_sizes, int n_in, void* d_out, int out_size, void* d_ws, size_t ws_size, hipStream_t stream) {
    static int grid = 0;
    if (grid == 0) {
        int dev = 0, cus = 0, per_cu = 0;
        hipGetDevice(&dev);
        hipDeviceGetAttribute(&cus, hipDeviceAttributeMultiprocessorCount, dev);
        hipFuncSetAttribute((const void*)fwd_kernel, hipFuncAttributeMaxDynamicSharedMemorySize, LDS_BYTES);
        hipOccupancyMaxActiveBlocksPerMultiprocessor(&per_cu, (const void*)fwd_kernel, 512, LDS_BYTES);
        (void)hipGetLastError();
        grid = cus > 0 ? cus : 256;
        if (n_in != 27 || ws_size < WS_END) { fprintf(stderr, "kernel_launch: unexpected n_in %d / ws %zu\n", n_in, ws_size); }
        if (per_cu < 1) fprintf(stderr, "kernel_launch: occupancy query says %d blocks per CU\n", per_cu);
    }
    if (hipMemsetAsync((char*)d_ws + WS_CTL, 0, CTL_BYTES, stream) != hipSuccess) fprintf(stderr, "kernel_launch: memset of barrier words failed\n");
    Args a{};
    for (int i = 0; i < 27; ++i) a.in[i] = (const float*)d_in[i];
    a.out = (float*)d_out; a.ws = (unsigned char*)d_ws;
    if (N_LAUNCH == 1) {
        a.ph_lo = 0; a.ph_hi = 11;
        void* kargs[] = {&a};
        hipError_t e = hipLaunchCooperativeKernel((const void*)fwd_kernel, dim3(grid), dim3(512), kargs, LDS_BYTES, stream);
        if (e != hipSuccess) fprintf(stderr, "cooperative launch failed: %s (grid %d)\n", hipGetErrorString(e), grid);
    } else {
        for (int p = 0; p < 11; ++p) { a.ph_lo = p; a.ph_hi = p + 1; hipLaunchKernelGGL(fwd_kernel, dim3(grid), dim3(512), LDS_BYTES, stream, a); }
    }
}
```
